# Optimizing an MI355X kernel written in HIP

```python
import jax, jax.numpy as jnp
from jax import lax
import numpy as np

D_MODEL = 1024
BATCH = 8
SEQ = 4096
DEPTH = 1

MIX_WIDTH = D_MODEL
ATTN_WIDTH = MIX_WIDTH // 2
SGU_WIDTH = MIX_WIDTH - ATTN_WIDTH
HEAD_DIM = 64
N_Q_HEADS = ATTN_WIDTH // HEAD_DIM
N_KV_HEADS = 2
Q_PER_KV = N_Q_HEADS // N_KV_HEADS
KV_WIDTH = N_KV_HEADS * HEAD_DIM
WINDOW = 128
BLOCK = 128
ROPE_THETA = 500000.0
ROT_DIM = HEAD_DIM // 4
SGU_CHUNK = 128
N_SGU_GROUPS = 4
SGU_GROUP_DIM = SGU_WIDTH // N_SGU_GROUPS
D_FF = -(-8 * D_MODEL // (3 * 256)) * 256
IN_WIDTH = ATTN_WIDTH + 2 * KV_WIDTH + 2 * SGU_WIDTH
LN_EPS = 1e-5
ALPHA = (2.0 * DEPTH) ** 0.25
BETA = (8.0 * DEPTH) ** -0.25

kernel_name = "hybrid_swa_sink_gmlp_deepnorm_block"


def layer_norm(x, g, b):
    x32 = x.astype(jnp.float32)
    mu = jnp.mean(x32, axis=-1, keepdims=True)
    var = jnp.mean(jnp.square(x32 - mu), axis=-1, keepdims=True)
    y = (x32 - mu) * lax.rsqrt(var + LN_EPS) * g.astype(jnp.float32) + b.astype(jnp.float32)
    return y.astype(x.dtype)


def rope_tables(positions):
    inv_freq = ROPE_THETA ** (-jnp.arange(0, ROT_DIM, 2, dtype=jnp.float32) / ROT_DIM)
    ang = positions.astype(jnp.float32)[..., None] * inv_freq
    return jnp.cos(ang)[:, :, None, :], jnp.sin(ang)[:, :, None, :]


def apply_partial_rope(t, cos, sin):
    half = ROT_DIM // 2
    t1 = t[..., :half].astype(jnp.float32)
    t2 = t[..., half:ROT_DIM].astype(jnp.float32)
    rot = jnp.concatenate([t1 * cos - t2 * sin, t2 * cos + t1 * sin], axis=-1).astype(t.dtype)
    return jnp.concatenate([rot, t[..., ROT_DIM:]], axis=-1)


def sliding_window_attention(q, k, v, sinks):
    b, s = q.shape[0], q.shape[1]
    nb = s // BLOCK
    qb = q.reshape(b, nb, BLOCK, N_KV_HEADS, Q_PER_KV, HEAD_DIM)

    def band(t):
        cur = t.reshape(b, nb, BLOCK, N_KV_HEADS, HEAD_DIM)
        prev = jnp.pad(cur, ((0, 0), (1, 0), (0, 0), (0, 0), (0, 0)))[:, :-1]
        return jnp.concatenate([prev, cur], axis=2)

    kb, vb = band(k), band(v)
    scores = jnp.einsum('bnqkgd,bnskd->bnkgqs', qb, kb).astype(jnp.float32) * (HEAD_DIM ** -0.5)
    qi = jnp.arange(BLOCK)[:, None]
    kj = jnp.arange(2 * BLOCK)[None, :]
    rel = qi + BLOCK - kj
    kpos = jnp.arange(nb)[:, None, None] * BLOCK + kj - BLOCK
    allowed = (rel >= 0) & (rel < WINDOW) & (kpos >= 0)
    scores = jnp.where(allowed[None, :, None, None, :, :], scores, -1e30)
    sink = jnp.broadcast_to(
        sinks.astype(jnp.float32).reshape(N_KV_HEADS, Q_PER_KV)[None, None, :, :, None, None],
        scores.shape[:-1] + (1,))
    probs = jax.nn.softmax(jnp.concatenate([scores, sink], axis=-1), axis=-1)[..., :-1]
    out = jnp.einsum('bnkgqs,bnskd->bnqkgd', probs.astype(v.dtype), vb)
    return out.reshape(b, s, ATTN_WIDTH)


def spatial_gating(su, sv, ln_g, ln_b, w_s, b_s):
    b, s = su.shape[0], su.shape[1]
    nc = s // SGU_CHUNK
    u = jax.nn.gelu(su, approximate=False)
    vv = layer_norm(jax.nn.gelu(sv, approximate=False), ln_g, ln_b)
    vv = vv.reshape(b, nc, SGU_CHUNK, N_SGU_GROUPS, SGU_GROUP_DIM)
    causal = jnp.tril(jnp.ones((SGU_CHUNK, SGU_CHUNK), dtype=w_s.dtype))
    mixed = jnp.einsum('hts,bcshd->bcthd', w_s * causal, vv) + b_s.T[:, :, None]
    return u * mixed.reshape(b, s, SGU_WIDTH)


def swiglu(h, w_gate, w_up, w_down):
    return (jax.nn.silu(h @ w_gate) * (h @ w_up)) @ w_down


def setup_inputs(seed: int = 0) -> dict:
    key = jax.random.key(seed)
    ks = jax.random.split(key, 24)
    f32 = jnp.float32
    L = DEPTH

    def nrm(k, shape, scale):
        return jax.random.normal(k, shape, f32) * scale

    x = jax.random.normal(ks[0], (BATCH, SEQ, D_MODEL), f32)
    positions = jnp.broadcast_to(jnp.arange(SEQ, dtype=jnp.int32)[None, :], (BATCH, SEQ))
    col_scale = jnp.concatenate([
        jnp.ones((ATTN_WIDTH + KV_WIDTH,), f32),
        jnp.full((KV_WIDTH,), BETA, f32),
        jnp.full((2 * SGU_WIDTH,), BETA, f32)])
    w_in = nrm(ks[1], (L, D_MODEL, IN_WIDTH), D_MODEL ** -0.5) * col_scale
    return {
        "x": x,
        "positions": positions,
        "ln_in_g": 1.0 + nrm(ks[2], (D_MODEL,), 0.02),
        "ln_in_b": nrm(ks[3], (D_MODEL,), 0.02),
        "w_in": w_in,
        "b_in": nrm(ks[4], (L, IN_WIDTH), 0.02),
        "attn_sinks": nrm(ks[5], (L, N_Q_HEADS), 0.5),
        "sgu_ln_g": 1.0 + nrm(ks[6], (L, SGU_WIDTH), 0.02),
        "sgu_ln_b": nrm(ks[7], (L, SGU_WIDTH), 0.02),
        "sgu_w": nrm(ks[8], (L, N_SGU_GROUPS, SGU_CHUNK, SGU_CHUNK), 0.5 * SGU_CHUNK ** -0.5),
        "sgu_b": 1.0 + nrm(ks[9], (L, N_SGU_GROUPS, SGU_CHUNK), 0.1),
        "w_out": nrm(ks[10], (L, MIX_WIDTH, D_MODEL), BETA * MIX_WIDTH ** -0.5),
        "b_out": nrm(ks[11], (L, D_MODEL), 0.02),
        "ln_mix_g": 1.0 + nrm(ks[12], (L, D_MODEL), 0.02),
        "ln_mix_b": nrm(ks[13], (L, D_MODEL), 0.02),
        "w_gate": nrm(ks[14], (L, D_MODEL, D_FF), BETA * D_MODEL ** -0.5),
        "w_up": nrm(ks[15], (L, D_MODEL, D_FF), BETA * D_MODEL ** -0.5),
        "w_down": nrm(ks[16], (L, D_FF, D_MODEL), BETA * D_FF ** -0.5),
        "ln_ffn_g": 1.0 + nrm(ks[17], (L, D_MODEL), 0.02),
        "ln_ffn_b": nrm(ks[18], (L, D_MODEL), 0.02),
    }


def reference(x, positions, ln_in_g, ln_in_b, w_in, b_in, attn_sinks, sgu_ln_g, sgu_ln_b,
              sgu_w, sgu_b, w_out, b_out, ln_mix_g, ln_mix_b, w_gate, w_up, w_down,
              ln_ffn_g, ln_ffn_b):
    b, s, _ = x.shape
    cos, sin = rope_tables(positions)
    h = layer_norm(x, ln_in_g, ln_in_b)
    splits = [ATTN_WIDTH, ATTN_WIDTH + KV_WIDTH, ATTN_WIDTH + 2 * KV_WIDTH,
              ATTN_WIDTH + 2 * KV_WIDTH + SGU_WIDTH]
    for l in range(DEPTH):
        proj = h @ w_in[l] + b_in[l]
        q, k, v, su, sv = jnp.split(proj, splits, axis=-1)
        q = apply_partial_rope(q.reshape(b, s, N_Q_HEADS, HEAD_DIM), cos, sin)
        k = apply_partial_rope(k.reshape(b, s, N_KV_HEADS, HEAD_DIM), cos, sin)
        v = v.reshape(b, s, N_KV_HEADS, HEAD_DIM)
        attn = sliding_window_attention(q, k, v, attn_sinks[l])
        sgu = spatial_gating(su, sv, sgu_ln_g[l], sgu_ln_b[l], sgu_w[l], sgu_b[l])
        mix = jnp.concatenate([attn, sgu], axis=-1) @ w_out[l] + b_out[l]
        h = layer_norm(ALPHA * h + mix, ln_mix_g[l], ln_mix_b[l])
        ffn = swiglu(h, w_gate[l], w_up[l], w_down[l])
        h = layer_norm(ALPHA * h + ffn, ln_ffn_g[l], ln_ffn_b[l])
    return h
```

```cpp
#include <hip/hip_runtime.h>
#include <hip/hip_cooperative_groups.h>
#include <cstdio>
#include <cstdint>
namespace cg = cooperative_groups;
namespace pg8 {
#define PG8_LAS __attribute__((address_space(3)))
typedef unsigned short bf16_t;
typedef short bf16x8 __attribute__((ext_vector_type(8)));
typedef float f32x4 __attribute__((ext_vector_type(4)));
typedef unsigned u32x4 __attribute__((ext_vector_type(4)));
constexpr int BM = 256, BK = 64, HALF = 128, HTB = HALF * BK * 2  , STAGE_BYTES = 8 * HTB, NXCD = 8, WGM = 8;

__host__ __device__ __forceinline__ int lds_byte(int r, int c) { const int st = (r >> 4) * 2 + (c >> 5), rr = r & 15, cc = c & 31, ob = rr * 64 + cc * 2; return st * 1024 + (ob ^ (((ob >> 9) & 1) << 5)); }
__host__ __device__ __forceinline__ void stage_rc(int b, int& R, int& C) { const int st = b / 1024, sb = b % 1024, swz = sb ^ (((sb >> 9) & 1) << 5); R = (st >> 1) * 16 + swz / 64; C = (st & 1) * 32 + (swz % 64) / 2; }
__host__ __device__ __forceinline__ int perm32(int rho) { const int n = rho >> 4, i = rho & 15; return 8 * (i >> 2) + 4 * n + (i & 3); }

struct Unit { int pm, pn; };
struct Gemm { const bf16_t* A; const bf16_t* Bt; int M, N, K; };

struct StaticOrder {
    int nM, nN, nwg, G, c;
    __host__ __device__ void init(int M, int N, int G_, int c_) { nM = M / BM; nN = N / BM; nwg = nM * nN; G = G_; c = c_; }
    __host__ __device__ bool next(int i, Unit& u) const {
        const long L = (long)i * G + c; if (L >= nwg) return false;
        int wgid = (int)L; { const int q = nwg / NXCD, r = nwg % NXCD, xcd = wgid % NXCD, off = wgid / NXCD; wgid = (xcd < r ? xcd * (q + 1) : r * (q + 1) + (xcd - r) * q) + off; }
        const int nig = WGM * nN, gid = wgid / nig, fm = gid * WGM, gsz = (nM - fm) < WGM ? (nM - fm) : WGM;
        u.pm = fm + ((wgid % nig) % gsz); u.pn = (wgid % nig) / gsz; return true;
    }
    __device__ __forceinline__ void a_ready(const Unit&) const {}
    __device__ __forceinline__ void done(const Unit&) const {}
};

__device__ __forceinline__ unsigned cvt_pk_bf16(float lo, float hi) { unsigned r; asm volatile("v_cvt_pk_bf16_f32 %0, %1, %2" : "=v"(r) : "v"(lo), "v"(hi)); return r; }
typedef float f32x2 __attribute__((ext_vector_type(2)));
__device__ __forceinline__ f32x2 gelu_pk(f32x2 v) {
    const f32x2 av = __builtin_elementwise_abs(v), d = av * 0.2316418882f + 1.0f;
    f32x2 t; t.x = __builtin_amdgcn_rcpf(d.x); t.y = __builtin_amdgcn_rcpf(d.y);
    f32x2 q = t * 0.5307027145f + (-0.7265760135f); q = q * t + 0.7107068705f; q = q * t + (-0.142248368f); q = q * t + 0.127414796f; q = q * t;
    const f32x2 s = (v * v) * (-0.72134752044f);
    f32x2 e; e.x = __builtin_amdgcn_exp2f(s.x); e.y = __builtin_amdgcn_exp2f(s.y);
    const f32x2 m = v * (q * e), r = v - m;
    f32x2 o; o.x = v.x < 0.f ? m.x : r.x; o.y = v.y < 0.f ? m.y : r.y; return o;
}
typedef unsigned u32x2 __attribute__((ext_vector_type(2)));
struct EpiIn {
    static constexpr bool PERM = true, AFTER_DRAIN = false;
    bf16_t* Qb; bf16_t* KVb; bf16_t* GU; bf16_t* GV; const float* bias; float qscale;
    __device__ __forceinline__ void operator()(const f32x4 (&acc)[2][2][4][2], const Unit& u, int wr, int wc, int fr, int fq) const {
        const int rowu = u.pm * BM + wr * 64;
#pragma unroll
        for (int bj = 0; bj < 2; ++bj) {
            const int colu = u.pn * BM + bj * HALF + wc * 32;
            const int ctile = u.pn * 2 + bj;
            bf16_t* base; int ld; int coff; int kind;
            if (ctile < 4) { base = Qb; ld = 512; coff = colu; kind = 0; }
            else if (ctile < 6) { base = KVb; ld = 256; coff = colu - 512; kind = 1; }
            else if (ctile < 10) { base = GU; ld = 512; coff = colu - 768; kind = 3; }
            else { base = GV; ld = 512; coff = colu - 1280; kind = 3; }
            char* ob = (char*)base + ((size_t)rowu * ld + coff) * 2;
            const unsigned voff = (unsigned)(fr * ld * 2 + fq * 16);
            const char* bb = (const char*)bias + (size_t)colu * 4;
            const f32x4 bv0 = *(const f32x4*)(bb + fq * 32), bv1 = *(const f32x4*)(bb + fq * 32 + 16);
#pragma unroll
            for (int ai = 0; ai < 2; ++ai)
#pragma unroll
                for (int m = 0; m < 4; ++m) {
                    f32x4 v0 = acc[ai][bj][m][0] + bv0, v1 = acc[ai][bj][m][1] + bv1;
                    if (kind == 0) { v0 = v0 * qscale; v1 = v1 * qscale; }
                    if (kind == 3) { f32x2 a = gelu_pk((f32x2){v0[0], v0[1]}), b = gelu_pk((f32x2){v0[2], v0[3]}), c = gelu_pk((f32x2){v1[0], v1[1]}), d = gelu_pk((f32x2){v1[2], v1[3]});
                        v0 = (f32x4){a.x, a.y, b.x, b.y}; v1 = (f32x4){c.x, c.y, d.x, d.y}; }
                    u32x4 w; w.x = cvt_pk_bf16(v0[0], v0[1]); w.y = cvt_pk_bf16(v0[2], v0[3]); w.z = cvt_pk_bf16(v1[0], v1[1]); w.w = cvt_pk_bf16(v1[2], v1[3]);
                    *(u32x4*)(ob + (size_t)(ai * HALF + m * 16) * ld * 2 + voff) = w;
                }
        }
    }
};
struct EpiRes {
    static constexpr bool PERM = true, AFTER_DRAIN = false;
    const float* src; const float* stats; const float* g; const float* b; const float* bias; float* out; float alpha;
    __device__ __forceinline__ void operator()(const f32x4 (&acc)[2][2][4][2], const Unit& u, int wr, int wc, int fr, int fq) const {
        const unsigned voff = (unsigned)(fr * 4096 + fq * 32), voffs = (unsigned)(fr * 8), voffc = (unsigned)(fq * 32);
        const size_t ubase = ((size_t)(u.pm * BM + wr * 64) * 1024 + (size_t)(u.pn * BM + wc * 32)) * 4;
        const char* sb = (const char*)src + ubase; char* ob = (char*)out + ubase;
        const char* stb = (const char*)stats + (size_t)(u.pm * BM + wr * 64) * 8;
        const size_t cbase = (size_t)(u.pn * BM + wc * 32) * 4;
#pragma unroll
        for (int bj = 0; bj < 2; ++bj) {
            const char* gp = (const char*)g + cbase + bj * HALF * 4; const char* bp = (const char*)b + cbase + bj * HALF * 4;
            f32x4 g0 = *(const f32x4*)(gp + voffc) * alpha, g1 = *(const f32x4*)(gp + voffc + 16) * alpha;
            f32x4 b0 = *(const f32x4*)(bp + voffc) * alpha, b1 = *(const f32x4*)(bp + voffc + 16) * alpha;
            if (bias) { const char* bb = (const char*)bias + cbase + bj * HALF * 4; b0 += *(const f32x4*)(bb + voffc); b1 += *(const f32x4*)(bb + voffc + 16); }
#pragma unroll
            for (int ai = 0; ai < 2; ++ai) {
                f32x4 xa[4][2]; f32x2 sa[4];
#pragma unroll
                for (int m = 0; m < 4; ++m) { const size_t ro = ((size_t)(ai * HALF + m * 16) * 1024 + bj * HALF) * 4;
                    sa[m] = *(const f32x2*)(stb + (size_t)(ai * HALF + m * 16) * 8 + voffs); xa[m][0] = *(const f32x4*)(sb + ro + voff); xa[m][1] = *(const f32x4*)(sb + ro + voff + 16); }
#pragma unroll
                for (int m = 0; m < 4; ++m) { const size_t ro = ((size_t)(ai * HALF + m * 16) * 1024 + bj * HALF) * 4;
                    const f32x2 st = sa[m];
                    const f32x4 y0 = ((xa[m][0] - st.x) * st.y) * g0 + b0 + acc[ai][bj][m][0];
                    const f32x4 y1 = ((xa[m][1] - st.x) * st.y) * g1 + b1 + acc[ai][bj][m][1];
                    *(f32x4*)(ob + ro + voff) = y0; *(f32x4*)(ob + ro + voff + 16) = y1;
                }
            }
        }
    }
};
struct EpiSwiglu {
    static constexpr bool PERM = true, AFTER_DRAIN = false;
    bf16_t* O; int ldo;
    __device__ __forceinline__ void operator()(const f32x4 (&acc)[2][2][4][2], const Unit& u, int wr, int wc, int fr, int fq) const {
        char* ob = (char*)O + ((size_t)(u.pm * BM + wr * 64) * ldo + u.pn * 128 + wc * 32) * 2;
        const unsigned voff = (unsigned)(fr * ldo * 2 + fq * 16);
#pragma unroll
        for (int ai = 0; ai < 2; ++ai)
#pragma unroll
            for (int m = 0; m < 4; ++m) {
                float a[8];
#pragma unroll
                for (int n = 0; n < 2; ++n)
#pragma unroll
                    for (int e = 0; e < 4; ++e) { const float gt = acc[ai][0][m][n][e], up = acc[ai][1][m][n][e];
                        const float ex = __builtin_amdgcn_exp2f(gt * -1.44269504089f); a[4 * n + e] = gt * __builtin_amdgcn_rcpf(1.0f + ex) * up; }
                u32x4 w; w.x = cvt_pk_bf16(a[0], a[1]); w.y = cvt_pk_bf16(a[2], a[3]); w.z = cvt_pk_bf16(a[4], a[5]); w.w = cvt_pk_bf16(a[6], a[7]);
                __builtin_nontemporal_store(w, (u32x4*)(ob + (size_t)(ai * HALF + m * 16) * ldo * 2 + voff));
            }
    }
};
struct EpiPlainBf16 {
    static constexpr bool PERM = true, AFTER_DRAIN = false;
    bf16_t* O; int ldo; const float* bias;
    __device__ __forceinline__ void operator()(const f32x4 (&acc)[2][2][4][2], const Unit& u, int wr, int wc, int fr, int fq) const {
        char* ob = (char*)O + ((size_t)(u.pm * BM + wr * 64) * ldo + u.pn * BM + wc * 32) * 2;
        const unsigned voff = (unsigned)(fr * ldo * 2 + fq * 16);
#pragma unroll
        for (int bj = 0; bj < 2; ++bj) {
            f32x4 bv0 = (f32x4){0.f, 0.f, 0.f, 0.f}, bv1 = bv0;
            if (bias) { const char* bb = (const char*)bias + (size_t)(u.pn * BM + bj * HALF + wc * 32) * 4; bv0 = *(const f32x4*)(bb + fq * 32); bv1 = *(const f32x4*)(bb + fq * 32 + 16); }
#pragma unroll
            for (int ai = 0; ai < 2; ++ai)
#pragma unroll
                for (int m = 0; m < 4; ++m) {
                    const f32x4 v0 = acc[ai][bj][m][0] + bv0, v1 = acc[ai][bj][m][1] + bv1;
                    u32x4 w; w.x = cvt_pk_bf16(v0[0], v0[1]); w.y = cvt_pk_bf16(v0[2], v0[3]); w.z = cvt_pk_bf16(v1[0], v1[1]); w.w = cvt_pk_bf16(v1[2], v1[3]);
                    *(u32x4*)(ob + ((size_t)(ai * HALF + m * 16) * ldo + bj * HALF) * 2 + voff) = w;
                }
        }
    }
};
template <class Epi, class Sched, bool ALIGN_EPI = false, bool SP2 = false>
__device__ __forceinline__ void gemm_phase(PG8_LAS unsigned char* lds, const Gemm g, const Sched& S, const Epi& E) {
    int tid_ = threadIdx.x; asm volatile("" : "+v"(tid_));
    const int tid = tid_, wid = __builtin_amdgcn_readfirstlane(tid >> 6), lane = tid & 63, wr = wid >> 2, wc = wid & 3, fr = lane & 15, fq = lane >> 4;
    const int K = g.K, nt = K / BK;
    unsigned voffA[2], voffB[2];
#pragma unroll
    for (int i = 0; i < 2; ++i) { int R, C; stage_rc(tid * 16 + i * 8192, R, C); const int Rb = Epi::PERM ? ((R & ~31) + perm32(R & 31)) : R;
        voffA[i] = (unsigned)(R * K + C) * 2u; voffB[i] = (unsigned)(Rb * K + C) * 2u; }
    const size_t kstep = (size_t)(BK * 2);
    const size_t hstep = (size_t)HALF * K * 2;
    const size_t tstep = 2 * hstep;
    const unsigned ldsw = (unsigned)wid * 1024u;
    const int aoff = lds_byte(wr * 64 + fr, fq * 8), boff = lds_byte(wc * 32 + fr, fq * 8);
#define PG8_SA(b, h) (((b) * 2 + (h)) * HTB)
#define PG8_SB(b, h) ((4 + (b) * 2 + (h)) * HTB)
#define PG8_STAGE(bufoff, gbase, voff) do { _Pragma("unroll") for (int _i = 0; _i < 2; ++_i) \
        __builtin_amdgcn_global_load_lds((const unsigned*)((const char*)(gbase) + (voff)[_i]), (PG8_LAS unsigned*)(lds + (bufoff) + ldsw + _i * 8192), 16, 0, 0); } while (0)
#define PG8_LDA(dst, b, h) do { _Pragma("unroll") for (int m = 0; m < 4; ++m) _Pragma("unroll") for (int k = 0; k < 2; ++k) dst[m][k] = *(const PG8_LAS bf16x8*)(lds + PG8_SA(b, h) + aoff + m * 2048 + k * 1024); } while (0)
#define PG8_LDB(dst, b, h) do { _Pragma("unroll") for (int n = 0; n < 2; ++n) _Pragma("unroll") for (int k = 0; k < 2; ++k) dst[n][k] = *(const PG8_LAS bf16x8*)(lds + PG8_SB(b, h) + boff + n * 2048 + k * 1024); } while (0)
#define PG8_MMA(ai, bj, At, Bt) do { __builtin_amdgcn_s_setprio(1); _Pragma("unroll") for (int m = 0; m < 4; ++m) _Pragma("unroll") for (int n = 0; n < 2; ++n) _Pragma("unroll") for (int k = 0; k < 2; ++k) \
        acc[ai][bj][m][n] = __builtin_amdgcn_mfma_f32_16x16x32_bf16(Bt[n][k], At[m][k], acc[ai][bj][m][n], 0, 0, 0); __builtin_amdgcn_s_setprio(0); } while (0)
#define PG8_WAIT_V(n) asm volatile("s_waitcnt vmcnt(" #n ")" ::: "memory")
#define PG8_WAIT_L(n) asm volatile("s_waitcnt lgkmcnt(" #n ")" ::: "memory")
#define PG8_BAR __builtin_amdgcn_s_barrier()
#define PG8_SCHED __builtin_amdgcn_sched_barrier(0)
    Unit cur, nxt; int ui = 0;
    if (!S.next(0, cur)) return;
    f32x4 acc[2][2][4][2];
#pragma unroll
    for (int a = 0; a < 2; ++a)
#pragma unroll
        for (int b = 0; b < 2; ++b)
#pragma unroll
            for (int m = 0; m < 4; ++m)
#pragma unroll
                for (int n = 0; n < 2; ++n) acc[a][b][m][n] = (f32x4){0.f, 0.f, 0.f, 0.f};
    bf16x8 At[4][2], B0[2][2], B1[2][2];
    const char* cA = (const char*)g.A + (size_t)cur.pm * tstep; const char* cB = (const char*)g.Bt + (size_t)cur.pn * tstep;
    S.a_ready(cur);
    if constexpr (SP2) {
        PG8_STAGE(PG8_SB(0, 0), cB, voffB); PG8_STAGE(PG8_SB(0, 1), cB + hstep, voffB); PG8_STAGE(PG8_SA(0, 0), cA, voffA); PG8_STAGE(PG8_SA(0, 1), cA + hstep, voffA);
        if (wr == 1) PG8_BAR;
        PG8_WAIT_V(2); PG8_BAR;
        PG8_STAGE(PG8_SB(1, 0), cB + kstep, voffB); PG8_STAGE(PG8_SA(1, 0), cA + kstep, voffA); PG8_STAGE(PG8_SB(1, 1), cB + hstep + kstep, voffB);
        PG8_WAIT_V(6); PG8_BAR;
    } else {
        PG8_STAGE(PG8_SB(0, 0), cB, voffB); PG8_STAGE(PG8_SA(0, 0), cA, voffA); PG8_STAGE(PG8_SB(0, 1), cB + hstep, voffB); PG8_STAGE(PG8_SA(0, 1), cA + hstep, voffA);
        if (wr == 1) PG8_BAR;
        PG8_WAIT_V(4); PG8_BAR;
        PG8_STAGE(PG8_SB(1, 0), cB + kstep, voffB); PG8_STAGE(PG8_SA(1, 0), cA + kstep, voffA); PG8_STAGE(PG8_SB(1, 1), cB + hstep + kstep, voffB);
        PG8_WAIT_V(6); PG8_BAR;
    }
    for (;;) {
        const bool has_next = S.next(ui + 1, nxt);
        const char* nA = has_next ? (const char*)g.A + (size_t)nxt.pm * tstep : cA; const char* nB = has_next ? (const char*)g.Bt + (size_t)nxt.pn * tstep : cB;
        for (int t = 0; t < nt; t += 2) {
            const bool last = (t == nt - 2);
            const char* a1 = cA + (size_t)(t + 1) * kstep;
            const char* a2 = last ? nA : cA + (size_t)(t + 2) * kstep; const char* b2 = last ? nB : cB + (size_t)(t + 2) * kstep;
            const char* a3 = a2 + kstep; const char* b3 = b2 + kstep;
            if (last && has_next) S.a_ready(nxt);
            if constexpr (SP2) {
            PG8_LDB(B0, 0, 0); PG8_LDB(B1, 0, 1); PG8_SCHED; PG8_LDA(At, 0, 0); PG8_STAGE(PG8_SA(1, 1), a1 + hstep, voffA);
            PG8_WAIT_V(8); PG8_WAIT_L(0); PG8_BAR; PG8_MMA(0, 0, At, B0); PG8_MMA(0, 1, At, B1); PG8_BAR; PG8_SCHED;
            PG8_LDA(At, 0, 1); PG8_STAGE(PG8_SB(0, 0), b2, voffB); PG8_STAGE(PG8_SB(0, 1), b2 + hstep, voffB); PG8_STAGE(PG8_SA(0, 0), a2, voffA);
            PG8_WAIT_V(8); PG8_WAIT_L(0); PG8_BAR; PG8_MMA(1, 0, At, B0); PG8_MMA(1, 1, At, B1); PG8_BAR; PG8_SCHED;
            PG8_LDB(B0, 1, 0); PG8_LDB(B1, 1, 1); PG8_SCHED; PG8_LDA(At, 1, 0); PG8_STAGE(PG8_SA(0, 1), a2 + hstep, voffA);
            PG8_WAIT_V(8); PG8_WAIT_L(0); PG8_BAR; PG8_MMA(0, 0, At, B0); PG8_MMA(0, 1, At, B1); PG8_BAR; PG8_SCHED;
            PG8_LDA(At, 1, 1); PG8_STAGE(PG8_SB(1, 0), b3, voffB); PG8_STAGE(PG8_SB(1, 1), b3 + hstep, voffB); PG8_STAGE(PG8_SA(1, 0), a3, voffA);
            PG8_WAIT_V(8); PG8_WAIT_L(0); PG8_BAR; PG8_MMA(1, 0, At, B0); PG8_MMA(1, 1, At, B1); PG8_BAR; PG8_SCHED;
            } else {
            PG8_LDB(B0, 0, 0); PG8_SCHED; PG8_LDA(At, 0, 0); PG8_STAGE(PG8_SA(1, 1), a1 + hstep, voffA);
            PG8_WAIT_L(8); PG8_BAR; PG8_WAIT_L(0); PG8_MMA(0, 0, At, B0); PG8_BAR; PG8_SCHED;
            PG8_LDB(B1, 0, 1); PG8_STAGE(PG8_SB(0, 0), b2, voffB);
            PG8_BAR; PG8_WAIT_L(0); PG8_MMA(0, 1, At, B1); PG8_BAR;
            PG8_LDA(At, 0, 1); PG8_STAGE(PG8_SA(0, 0), a2, voffA);
            PG8_BAR; PG8_WAIT_L(0); PG8_MMA(1, 0, At, B0); PG8_BAR; PG8_SCHED;
            PG8_STAGE(PG8_SB(0, 1), b2 + hstep, voffB);
            PG8_WAIT_V(6); PG8_BAR; PG8_MMA(1, 1, At, B1); PG8_BAR;
            PG8_LDB(B0, 1, 0); PG8_SCHED; PG8_LDA(At, 1, 0); PG8_STAGE(PG8_SA(0, 1), a2 + hstep, voffA);
            PG8_WAIT_L(8); PG8_BAR; PG8_WAIT_L(0); PG8_MMA(0, 0, At, B0); PG8_BAR; PG8_SCHED;
            PG8_LDB(B1, 1, 1); PG8_STAGE(PG8_SB(1, 0), b3, voffB);
            PG8_BAR; PG8_WAIT_L(0); PG8_MMA(0, 1, At, B1); PG8_BAR;
            PG8_LDA(At, 1, 1); PG8_STAGE(PG8_SA(1, 0), a3, voffA);
            PG8_BAR; PG8_WAIT_L(0); PG8_MMA(1, 0, At, B0); PG8_BAR; PG8_SCHED;
            PG8_STAGE(PG8_SB(1, 1), b3 + hstep, voffB);
            PG8_WAIT_V(6); PG8_BAR; PG8_MMA(1, 1, At, B1); PG8_BAR;
            }
        }
        if constexpr (ALIGN_EPI) { if (wr == 0) PG8_BAR; }
        if constexpr (!Epi::AFTER_DRAIN) { E(acc, cur, wr, wc, fr, fq); S.done(cur); }
        if (!has_next) break;
#pragma unroll
        for (int a = 0; a < 2; ++a)
#pragma unroll
            for (int b = 0; b < 2; ++b)
#pragma unroll
                for (int m = 0; m < 4; ++m)
#pragma unroll
                    for (int n = 0; n < 2; ++n) acc[a][b][m][n] = (f32x4){0.f, 0.f, 0.f, 0.f};
        cur = nxt; cA = nA; cB = nB; ++ui;
        if constexpr (ALIGN_EPI) { if (wr == 1) PG8_BAR; }
    }
    PG8_WAIT_V(0);
    if constexpr (!ALIGN_EPI) { if (wr == 0) PG8_BAR; }
    PG8_BAR;
    if constexpr (Epi::AFTER_DRAIN) { E.fused(acc, cur, wr, wc, fr, fq, lds, wid, lane); S.done(cur); }
#undef PG8_SA
#undef PG8_SB
#undef PG8_STAGE
#undef PG8_LDA
#undef PG8_LDB
#undef PG8_MMA
#undef PG8_WAIT_V
#undef PG8_WAIT_L
#undef PG8_BAR
#undef PG8_SCHED
}
}

constexpr int NWAVES = 8;
constexpr int BATCH = 8, SEQ = 4096, D = 1024, M = BATCH * SEQ;
constexpr int NIN = 1792, DFF = 2816, NGU = 2 * DFF;
constexpr float LN_EPS = 1e-5f;
constexpr float ALPHA = 1.189207115002721f;
constexpr float QSCALE = 0.125f * 1.44269504089f;
constexpr float LOG2E = 1.44269504089f;
constexpr size_t MiB = 1u << 20;
constexpr size_t WS_BAR = 0;
constexpr size_t WS_WIN = 1 * MiB, WS_WO = 5 * MiB, WS_WGU = 7 * MiB, WS_WD = 18 * MiB;
constexpr size_t WS_WS = 24 * MiB, WS_ST0 = 24 * MiB + 512 * 1024, WS_ST1 = 24 * MiB + 768 * 1024, WS_ROPE = 25 * MiB;
constexpr size_t WS_XN = 32 * MiB;
constexpr size_t WS_MIX = 96 * MiB;
constexpr size_t WS_FFN = 160 * MiB;
constexpr size_t WS_Q = 224 * MiB, WS_KV = 256 * MiB, WS_GU = 272 * MiB, WS_GV = 304 * MiB, WS_CAT = 336 * MiB;
constexpr size_t WS_ACT = 224 * MiB;
constexpr size_t WS_END = 400 * MiB;
static_assert(WS_ACT + (size_t)M * DFF * 2 <= WS_END && WS_CAT + (size_t)M * D * 2 <= WS_END, "ws map");
constexpr int LDS_BYTES = 147456;

#define GAS __attribute__((address_space(1)))
#define LAS __attribute__((address_space(3)))
typedef unsigned short bf16;
typedef unsigned v4u __attribute__((ext_vector_type(4)));
typedef unsigned v2u __attribute__((ext_vector_type(2)));
typedef float f32x4 __attribute__((ext_vector_type(4)));
typedef float f32x2 __attribute__((ext_vector_type(2)));
typedef short bf16x8 __attribute__((ext_vector_type(8)));
typedef short s16x4 __attribute__((ext_vector_type(4)));
#define RLX_AGENT __ATOMIC_RELAXED, __HIP_MEMORY_SCOPE_AGENT
#define LDS_WAIT() asm volatile("s_waitcnt lgkmcnt(0)" ::: "memory")
__device__ __forceinline__ unsigned pk2(float lo, float hi) { return pg8::cvt_pk_bf16(lo, hi); }
__device__ __forceinline__ float bflo(unsigned w) { return __builtin_bit_cast(float, w << 16); }
__device__ __forceinline__ float bfhi(unsigned w) { return __builtin_bit_cast(float, w & 0xffff0000u); }
template <int CTRL, int ROWMASK> __device__ __forceinline__ float dpp_add(float v) {
    return v + __builtin_bit_cast(float, __builtin_amdgcn_update_dpp(0, __builtin_bit_cast(int, v), CTRL, ROWMASK, 0xf, false));
}
__device__ __forceinline__ float wave_sum_u(float v) {
    v = dpp_add<0xB1, 0xf>(v); v = dpp_add<0x4E, 0xf>(v); v = dpp_add<0x141, 0xf>(v); v = dpp_add<0x140, 0xf>(v);
    v = dpp_add<0x142, 0xa>(v); v = dpp_add<0x143, 0xc>(v);
    return __builtin_bit_cast(float, __builtin_amdgcn_readlane(__builtin_bit_cast(int, v), 63));
}
__device__ __forceinline__ float wave_sum(float v) {
#pragma unroll
    for (int o = 1; o < 64; o <<= 1) v += __shfl_xor(v, o);
    return v;
}

#define XB_TMO      128
#define XB_XCNT(j)  (256  + 64 * (j))
#define XB_XSUB(j)  (1280 + 64 * (j))
#define XB_XGEN(j)  (2304 + 64 * (j))
#define XB_TOP      3328
#define XB_TOPGEN   3392
#define XCD_BAR_WORDS 3456
#define XB_SPIN_CAP (1u << 18)

__device__ __forceinline__ unsigned xb_ld(unsigned* p)              { return __hip_atomic_load(p, __ATOMIC_RELAXED, __HIP_MEMORY_SCOPE_AGENT); }
__device__ __forceinline__ unsigned xb_add(unsigned* p, unsigned v) { return __hip_atomic_fetch_add(p, v, __ATOMIC_RELAXED, __HIP_MEMORY_SCOPE_AGENT); }
__device__ __forceinline__ unsigned xb_xcc_id() { return (unsigned)__builtin_amdgcn_s_getreg((3 << 11) | 20) & 0xFu; }
#define XB_SPIN(cond, bar) do { unsigned _sp = 0; while (cond) { __builtin_amdgcn_s_sleep(1); \
    if ((++_sp & 255u) == 0u) { if (xb_ld(&(bar)[XB_TMO])) break; if (_sp > XB_SPIN_CAP) { atomicAdd(&(bar)[XB_TMO], 1u); break; } } } } while (0)

struct XcdBarrier {
    unsigned* bar; unsigned x;
    volatile LAS unsigned* st;
};

__device__ __forceinline__ XcdBarrier xcd_barrier_post(unsigned* bar, volatile LAS unsigned* st) {
    XcdBarrier b; b.bar = bar; b.x = xb_xcc_id(); b.st = st;
    if (threadIdx.x == 0) (void)xb_add(&bar[XB_XCNT(b.x)], 1u);
    return b;
}
__device__ __forceinline__ void xcd_barrier_complete(unsigned* bar, unsigned x, unsigned& nloc, unsigned& nx) {
    const unsigned G = gridDim.x * gridDim.y * gridDim.z;
    unsigned sum, cnt, mine, sp = 0u;
    for (;;) {
        sum = 0u; cnt = 0u; mine = 0u;
#pragma unroll
        for (unsigned j = 0; j < 16; ++j) { const unsigned c = xb_ld(&bar[XB_XCNT(j)]); sum += c; cnt += (c > 0u) ? 1u : 0u; mine = (j == x) ? c : mine; }
        if (sum == G) break;
        __builtin_amdgcn_s_sleep(1);
        if ((++sp & 255u) == 0u) { if (xb_ld(&bar[XB_TMO])) break; if (sp > XB_SPIN_CAP) { atomicAdd(&bar[XB_TMO], 1u); break; } }
    }
    nloc = mine > 0u ? mine : 1u; nx = cnt > 0u ? cnt : 1u;
}

__device__ __forceinline__ void xcd_barrier(const XcdBarrier& b) {
    asm volatile("s_waitcnt vmcnt(0)" ::: "memory");
    __syncthreads();
    if (threadIdx.x == 0) {
        unsigned* bar = b.bar;
        __builtin_amdgcn_s_waitcnt(0);
        unsigned nloc = b.st[0], nx = b.st[1];
        if (nloc == 0u) { xcd_barrier_complete(bar, b.x, nloc, nx); b.st[0] = nloc; b.st[1] = nx; }
        const unsigned old = xb_add(&bar[XB_XSUB(b.x)], 1u);
        const unsigned gen = old / nloc;
        if (old + 1u == (gen + 1u) * nloc) {
            __builtin_amdgcn_fence(__ATOMIC_RELEASE, "agent");
            asm volatile("s_waitcnt vmcnt(0)" ::: "memory");
            const unsigned og = xb_add(&bar[XB_TOP], 1u);
            const unsigned tg = og / nx;
            if (og + 1u == (tg + 1u) * nx) xb_add(&bar[XB_TOPGEN], 1u);
            else XB_SPIN(xb_ld(&bar[XB_TOPGEN]) == tg, bar);
            __builtin_amdgcn_fence(__ATOMIC_ACQUIRE, "agent");
            xb_add(&bar[XB_XGEN(b.x)], 1u);
            asm volatile("s_waitcnt vmcnt(0)" ::: "memory");
        } else {
            XB_SPIN(xb_ld(&bar[XB_XGEN(b.x)]) == gen, bar);
            __builtin_amdgcn_fence(__ATOMIC_ACQUIRE, "agent");
            asm volatile("s_waitcnt vmcnt(0)" ::: "memory");
        }
    }
    __syncthreads();
}

struct Frame {
    LAS unsigned char* lds;
    int tid, lane, wave, G, bx;
    const float* x; const int* pos; const float *ln_in_g, *ln_in_b, *w_in, *b_in, *sinks, *sgu_g, *sgu_b, *sgu_w, *sgu_bias, *w_out, *b_out, *ln_mix_g, *ln_mix_b, *w_gate, *w_up, *w_down, *ln_ffn_g, *ln_ffn_b;
    float* out;
    bf16 *WinT, *WoT, *WguT, *WdT, *Wsb, *XN, *Qb, *KVb, *GU, *GV, *CAT, *ACT;
    float *ST0; unsigned* ROPE; bf16 *MIX, *FFN;
};

__device__ __forceinline__ void p0_transpose_item(const float* W, int K, int N, bf16* WT, int mode, LAS float* scr, int item, int lane) {
    const int nblk = N / 32, kb = item / nblk, nb = item % nblk, k0 = 64 * kb, n0 = 32 * nb;
#pragma unroll 8
    for (int i = 0; i < 32; ++i) { const int kk = 2 * i + (lane >> 5); scr[kk * 33 + (lane & 31)] = __builtin_nontemporal_load(W + (size_t)(k0 + kk) * N + n0 + (lane & 31)); }
    LDS_WAIT(); asm volatile("" ::: "memory");
    const int c = lane & 7;
#pragma unroll
    for (int j = 0; j < 4; ++j) { const int n = (lane >> 3) + 8 * j; const LAS float* s = scr + (8 * c) * 33 + n;
        v4u o; o.x = pk2(s[0 * 33], s[1 * 33]); o.y = pk2(s[2 * 33], s[3 * 33]); o.z = pk2(s[4 * 33], s[5 * 33]); o.w = pk2(s[6 * 33], s[7 * 33]);
        const int ng = n0 + n; const int row = (mode == 0) ? ng : (((ng >> 7) << 8) + (ng & 127) + (mode == 2 ? 128 : 0));
        *(v4u*)(WT + (size_t)row * K + k0 + 8 * c) = o; }
    LDS_WAIT(); asm volatile("" ::: "memory");
}

template <int MODE, int R>
__device__ __forceinline__ void ln_rows(Frame& F, const float* src, const float* g, const float* b, bf16* ob, float* st, float* of) {
    const int gw = F.bx * NWAVES + F.wave, NGW = F.G * NWAVES;
    f32x4 gv[4], bv[4];
#pragma unroll
    for (int j = 0; j < 4; ++j) { gv[j] = *((const f32x4*)g + F.lane + 64 * j); bv[j] = *((const f32x4*)b + F.lane + 64 * j); }
    for (int m0 = gw * R; m0 < M; m0 += NGW * R) {
        f32x4 v[R][4]; float s[R], q[R];
#pragma unroll
        for (int r = 0; r < R; ++r) { const f32x4* xr = (const f32x4*)(src + (size_t)(m0 + r) * D) + F.lane;
#pragma unroll
            for (int j = 0; j < 4; ++j) v[r][j] = __builtin_nontemporal_load(xr + 64 * j); }
#pragma unroll
        for (int r = 0; r < R; ++r) { s[r] = 0.f;
#pragma unroll
            for (int j = 0; j < 4; ++j) s[r] += (v[r][j].x + v[r][j].y) + (v[r][j].z + v[r][j].w); }
#pragma unroll
        for (int r = 0; r < R; ++r) s[r] = wave_sum_u(s[r]);
#pragma unroll
        for (int r = 0; r < R; ++r) { s[r] *= (1.f / D); q[r] = 0.f;
#pragma unroll
            for (int j = 0; j < 4; ++j) { v[r][j] = v[r][j] - s[r]; q[r] += (v[r][j].x * v[r][j].x + v[r][j].y * v[r][j].y) + (v[r][j].z * v[r][j].z + v[r][j].w * v[r][j].w); } }
#pragma unroll
        for (int r = 0; r < R; ++r) q[r] = wave_sum_u(q[r]);
#pragma unroll
        for (int r = 0; r < R; ++r) {
            const float rstd = 1.f / sqrtf(q[r] * (1.f / D) + LN_EPS); const int m = m0 + r;
            if (MODE == 0) {
                v2u* o8 = (v2u*)(ob + (size_t)m * D) + F.lane;
#pragma unroll
                for (int j = 0; j < 4; ++j) { const f32x4 y = v[r][j] * rstd * gv[j] + bv[j]; v2u w; w.x = pk2(y.x, y.y); w.y = pk2(y.z, y.w); o8[64 * j] = w; }
                if (F.lane == 0) { st[2 * m] = s[r]; st[2 * m + 1] = rstd; }
            } else {
                f32x4* o = (f32x4*)(of + (size_t)m * D) + F.lane;
#pragma unroll
                for (int j = 0; j < 4; ++j) o[64 * j] = v[r][j] * rstd * gv[j] + bv[j];
            }
        }
    }
}

template <int NP, int R>
__device__ __forceinline__ void chain_rows(Frame& F, const bf16* mix, const bf16* ffn, bf16* ob, float* of) {
    const int gw = F.bx * NWAVES + F.wave, NGW = F.G * NWAVES;
    int ln = F.lane; asm volatile("" : "+v"(ln));
    for (int m0 = gw * R; m0 < M; m0 += NGW * R) {
        f32x4 v[R][4]; v2u mw[R][4], fw[R][4]; float s[R], q[R];
#pragma unroll
        for (int r = 0; r < R; ++r) { const f32x4* xr = (const f32x4*)(F.x + (size_t)(m0 + r) * D) + ln; const v2u* mr = (const v2u*)(mix + (size_t)(m0 + r) * D) + ln;
#pragma unroll
            for (int j = 0; j < 4; ++j) { v[r][j] = __builtin_nontemporal_load(xr + 64 * j); mw[r][j] = __builtin_nontemporal_load(mr + 64 * j); }
        }
#pragma unroll
        for (int pass = 0; pass < NP; ++pass) {
            if (NP == 3 && pass == 1) {
#pragma unroll
                for (int r = 0; r < R; ++r) { const v2u* fr_ = (const v2u*)(ffn + (size_t)(m0 + r) * D) + ln;
#pragma unroll
                    for (int j = 0; j < 4; ++j) fw[r][j] = __builtin_nontemporal_load(fr_ + 64 * j); } }
#pragma unroll
            for (int r = 0; r < R; ++r) { s[r] = 0.f;
#pragma unroll
                for (int j = 0; j < 4; ++j) s[r] += (v[r][j].x + v[r][j].y) + (v[r][j].z + v[r][j].w); }
#pragma unroll
            for (int r = 0; r < R; ++r) s[r] = wave_sum_u(s[r]);
#pragma unroll
            for (int r = 0; r < R; ++r) { s[r] *= (1.f / D); q[r] = 0.f;
#pragma unroll
                for (int j = 0; j < 4; ++j) { v[r][j] = v[r][j] - s[r]; q[r] += (v[r][j].x * v[r][j].x + v[r][j].y * v[r][j].y) + (v[r][j].z * v[r][j].z + v[r][j].w * v[r][j].w); } }
#pragma unroll
            for (int r = 0; r < R; ++r) q[r] = wave_sum_u(q[r]);
            float rstd[R];
#pragma unroll
            for (int r = 0; r < R; ++r) rstd[r] = 1.f / sqrtf(q[r] * (1.f / D) + LN_EPS);
            asm volatile("" ::: "memory");
            const float* gp = pass == 0 ? F.ln_in_g : (pass == 1 ? F.ln_mix_g : F.ln_ffn_g); const float* bp = pass == 0 ? F.ln_in_b : (pass == 1 ? F.ln_mix_b : F.ln_ffn_b);
#pragma unroll
            for (int j = 0; j < 4; ++j) { const f32x4 gv = *((const f32x4*)gp + ln + 64 * j), bv = *((const f32x4*)bp + ln + 64 * j);
#pragma unroll
                for (int r = 0; r < R; ++r) {
                    const f32x4 y = v[r][j] * rstd[r] * gv + bv;
                    if (pass == 0) { const f32x4 a = (f32x4){bflo(mw[r][j].x), bfhi(mw[r][j].x), bflo(mw[r][j].y), bfhi(mw[r][j].y)}; v[r][j] = y * ALPHA + a; }
                    else if (pass == 1 && NP == 2) { v2u w; w.x = pk2(y.x, y.y); w.y = pk2(y.z, y.w); *((v2u*)(ob + (size_t)(m0 + r) * D) + ln + 64 * j) = w; }
                    else if (pass == 1) { const f32x4 a = (f32x4){bflo(fw[r][j].x), bfhi(fw[r][j].x), bflo(fw[r][j].y), bfhi(fw[r][j].y)}; v[r][j] = y * ALPHA + a; }
                    else __builtin_nontemporal_store(y, (f32x4*)(of + (size_t)(m0 + r) * D) + ln + 64 * j); } }
        }
    }
}

template <int NP, int R>
__device__ __forceinline__ void cr_load(const float* x, const bf16* mix, const bf16* ffn, int m0, int ln, f32x4 (&v)[R][4], v2u (&mw)[R][4], v2u (&fw)[R][4]) {
#pragma unroll
    for (int r = 0; r < R; ++r) { const f32x4* xr = (const f32x4*)(x + (size_t)(m0 + r) * D) + ln; const v2u* mr = (const v2u*)(mix + (size_t)(m0 + r) * D) + ln;
#pragma unroll
        for (int j = 0; j < 4; ++j) { v[r][j] = __builtin_nontemporal_load(xr + 64 * j); mw[r][j] = __builtin_nontemporal_load(mr + 64 * j); }
        if (NP == 3) { const v2u* fr_ = (const v2u*)(ffn + (size_t)(m0 + r) * D) + ln;
#pragma unroll
            for (int j = 0; j < 4; ++j) fw[r][j] = __builtin_nontemporal_load(fr_ + 64 * j); } }
}
template <int NP, int R>
__device__ __forceinline__ void cr_process(const LAS float* GBL, int m0, int ln, f32x4 (&v)[R][4], v2u (&mw)[R][4], v2u (&fw)[R][4], bf16* ob, float* of) {
    float s[R], q[R], rstd[R];
#pragma unroll
    for (int pass = 0; pass < NP; ++pass) {
#pragma unroll
        for (int r = 0; r < R; ++r) { s[r] = 0.f;
#pragma unroll
            for (int j = 0; j < 4; ++j) s[r] += (v[r][j].x + v[r][j].y) + (v[r][j].z + v[r][j].w); }
#pragma unroll
        for (int r = 0; r < R; ++r) s[r] = wave_sum_u(s[r]);
#pragma unroll
        for (int r = 0; r < R; ++r) { s[r] *= (1.f / D); q[r] = 0.f;
#pragma unroll
            for (int j = 0; j < 4; ++j) { v[r][j] = v[r][j] - s[r]; q[r] += (v[r][j].x * v[r][j].x + v[r][j].y * v[r][j].y) + (v[r][j].z * v[r][j].z + v[r][j].w * v[r][j].w); } }
#pragma unroll
        for (int r = 0; r < R; ++r) q[r] = wave_sum_u(q[r]);
#pragma unroll
        for (int r = 0; r < R; ++r) rstd[r] = 1.f / sqrtf(q[r] * (1.f / D) + LN_EPS);
#pragma unroll
        for (int j = 0; j < 4; ++j) { const f32x4 gv = *(const LAS f32x4*)(GBL + (2 * pass) * 1024 + ln * 4 + 256 * j), bv = *(const LAS f32x4*)(GBL + (2 * pass + 1) * 1024 + ln * 4 + 256 * j);
#pragma unroll
            for (int r = 0; r < R; ++r) {
                const f32x4 y = v[r][j] * rstd[r] * gv + bv;
                if (pass == 0) { const f32x4 a = (f32x4){bflo(mw[r][j].x), bfhi(mw[r][j].x), bflo(mw[r][j].y), bfhi(mw[r][j].y)}; v[r][j] = y * ALPHA + a; }
                else if (pass == 1 && NP == 2) { v2u w; w.x = pk2(y.x, y.y); w.y = pk2(y.z, y.w); *((v2u*)(ob + (size_t)(m0 + r) * D) + ln + 64 * j) = w; }
                else if (pass == 1) { const f32x4 a = (f32x4){bflo(fw[r][j].x), bfhi(fw[r][j].x), bflo(fw[r][j].y), bfhi(fw[r][j].y)}; v[r][j] = y * ALPHA + a; }
                else __builtin_nontemporal_store(y, (f32x4*)(of + (size_t)(m0 + r) * D) + ln + 64 * j); } }
    }
}
template <int NP, int R>
__device__ __forceinline__ void chain_rows2(Frame& F, const bf16* mix, const bf16* ffn, bf16* ob, float* of) {
    LAS float* GBL = (LAS float*)F.lds;
    for (int i = F.tid; i < 1024; i += NWAVES * 64) { GBL[i] = F.ln_in_g[i]; GBL[1024 + i] = F.ln_in_b[i]; GBL[2048 + i] = F.ln_mix_g[i]; GBL[3072 + i] = F.ln_mix_b[i];
        if (NP == 3) { GBL[4096 + i] = F.ln_ffn_g[i]; GBL[5120 + i] = F.ln_ffn_b[i]; } }
    __syncthreads();
    int ln = F.lane; asm volatile("" : "+v"(ln));
    const int step = F.G * NWAVES * R; int m0 = (F.bx * NWAVES + F.wave) * R;
    f32x4 va[R][4], vb[R][4]; v2u ma[R][4], mb[R][4], fa[R][4], fb[R][4];
    if (m0 < M) cr_load<NP, R>(F.x, mix, ffn, m0, ln, va, ma, fa);
    while (m0 < M) {
        asm volatile("" : "+v"(ln));
        int m1 = m0 + step; if (m1 < M) cr_load<NP, R>(F.x, mix, ffn, m1, ln, vb, mb, fb);
        cr_process<NP, R>(GBL, m0, ln, va, ma, fa, ob, of);
        m0 = m1; if (m0 >= M) break;
        asm volatile("" : "+v"(ln));
        m1 = m0 + step; if (m1 < M) cr_load<NP, R>(F.x, mix, ffn, m1, ln, va, ma, fa);
        cr_process<NP, R>(GBL, m0, ln, vb, mb, fb, ob, of);
        m0 = m1;
    }
    __syncthreads();
}

template <int R>
__device__ __forceinline__ void l0_process(const LAS float* GBL, int m0, int ln, f32x4 (&v)[R][4], bf16* ob, float* st) {
    float s[R], q[R], rstd[R];
#pragma unroll
    for (int r = 0; r < R; ++r) { s[r] = 0.f;
#pragma unroll
        for (int j = 0; j < 4; ++j) s[r] += (v[r][j].x + v[r][j].y) + (v[r][j].z + v[r][j].w); }
#pragma unroll
    for (int r = 0; r < R; ++r) s[r] = wave_sum_u(s[r]);
#pragma unroll
    for (int r = 0; r < R; ++r) { s[r] *= (1.f / D); q[r] = 0.f;
#pragma unroll
        for (int j = 0; j < 4; ++j) { v[r][j] = v[r][j] - s[r]; q[r] += (v[r][j].x * v[r][j].x + v[r][j].y * v[r][j].y) + (v[r][j].z * v[r][j].z + v[r][j].w * v[r][j].w); } }
#pragma unroll
    for (int r = 0; r < R; ++r) q[r] = wave_sum_u(q[r]);
#pragma unroll
    for (int r = 0; r < R; ++r) rstd[r] = 1.f / sqrtf(q[r] * (1.f / D) + LN_EPS);
#pragma unroll
    for (int j = 0; j < 4; ++j) { const f32x4 gv = *(const LAS f32x4*)(GBL + ln * 4 + 256 * j), bv = *(const LAS f32x4*)(GBL + 1024 + ln * 4 + 256 * j);
#pragma unroll
        for (int r = 0; r < R; ++r) { const f32x4 y = v[r][j] * rstd[r] * gv + bv; v2u w; w.x = pk2(y.x, y.y); w.y = pk2(y.z, y.w); *((v2u*)(ob + (size_t)(m0 + r) * D) + ln + 64 * j) = w; } }
    if (ln == 0) {
#pragma unroll
        for (int r = 0; r < R; ++r) { st[2 * (m0 + r)] = s[r]; st[2 * (m0 + r) + 1] = rstd[r]; } }
}
template <int R>
__device__ __forceinline__ void l0_load(const float* src, int m0, int ln, f32x4 (&v)[R][4]) {
#pragma unroll
    for (int r = 0; r < R; ++r) { const f32x4* xr = (const f32x4*)(src + (size_t)(m0 + r) * D) + ln;
#pragma unroll
        for (int j = 0; j < 4; ++j) v[r][j] = __builtin_nontemporal_load(xr + 64 * j); }
}
template <int R>
__device__ __forceinline__ void ln_rows2(Frame& F, const float* src, const float* g, const float* b, bf16* ob, float* st) {
    LAS float* GBL = (LAS float*)F.lds;
    __syncthreads();
    for (int i = F.tid; i < 1024; i += NWAVES * 64) { GBL[i] = g[i]; GBL[1024 + i] = b[i]; }
    __syncthreads();
    int ln = F.lane; asm volatile("" : "+v"(ln));
    const int step = F.G * NWAVES * R; int m0 = (F.bx * NWAVES + F.wave) * R;
    f32x4 va[R][4], vb[R][4];
    if (m0 < M) l0_load<R>(src, m0, ln, va);
    while (m0 < M) {
        asm volatile("" : "+v"(ln));
        int m1 = m0 + step; if (m1 < M) l0_load<R>(src, m1, ln, vb);
        l0_process<R>(GBL, m0, ln, va, ob, st);
        m0 = m1; if (m0 >= M) break;
        asm volatile("" : "+v"(ln));
        m1 = m0 + step; if (m1 < M) l0_load<R>(src, m1, ln, va);
        l0_process<R>(GBL, m0, ln, vb, ob, st);
        m0 = m1;
    }
    __syncthreads();
}

constexpr int I_IN = (D / 64) * (NIN / 32), I_O = (D / 64) * (D / 32), I_G = (D / 64) * (DFF / 32), I_D = (DFF / 64) * (D / 32);
constexpr int NITEMS = I_IN + I_O + 2 * I_G + I_D;
constexpr int NWG1 = (M / 256) * (NIN / 256);
__device__ __forceinline__ void transpose_dispatch(Frame& F, int it, LAS float* scr) {
    int r = it;
    if (r < I_IN) { p0_transpose_item(F.w_in, D, NIN, F.WinT, 0, scr, r, F.lane); return; } r -= I_IN;
    if (r < I_O) { p0_transpose_item(F.w_out, D, D, F.WoT, 0, scr, r, F.lane); return; } r -= I_O;
    if (r < I_G) { p0_transpose_item(F.w_gate, D, DFF, F.WguT, 1, scr, r, F.lane); return; } r -= I_G;
    if (r < I_G) { p0_transpose_item(F.w_up, D, DFF, F.WguT, 2, scr, r, F.lane); return; } r -= I_G;
    p0_transpose_item(F.w_down, DFF, D, F.WdT, 0, scr, r, F.lane);
}
__device__ __forceinline__ void p1_tail_transposes(Frame& F) {
    const int rem = NWG1 % F.G;
    if (rem == 0 || F.bx < rem) return;
    LAS float* scr = (LAS float*)(F.lds + F.wave * 16384);
    const int tw = (F.bx - rem) * NWAVES + F.wave, NTW = (F.G - rem) * NWAVES;
    for (int it = I_IN + tw; it < NITEMS; it += NTW) transpose_dispatch(F, it, scr);
}
__device__ __forceinline__ void p0_prologue(Frame& F) {
    LAS float* scr = (LAS float*)(F.lds + F.wave * 16384);
    const int gw = F.bx * NWAVES + F.wave, NGW = F.G * NWAVES;
    const int nit0 = (NWG1 % F.G == 0) ? NITEMS : I_IN;
    for (int it = gw; it < nit0; it += NGW) transpose_dispatch(F, it, scr);
    const int gt = F.bx * (NWAVES * 64) + F.tid, NGT = F.G * NWAVES * 64;
    for (int i = gt; i < 4 * 128 * 128 / 2; i += NGT) { const int e = 2 * i, t = (e >> 7) & 127, s = e & 127; const float a = F.sgu_w[e], b = F.sgu_w[e + 1];
        ((unsigned*)F.Wsb)[i] = pk2(s <= t ? a : 0.f, (s + 1) <= t ? b : 0.f); }
    for (int i = gt; i < M * 8; i += NGT) { const int row = i >> 3, k = i & 7;
        const float invf[8] = {1.0f, 0.1939227432012558f, 0.03760603070259094f, 0.007292664609849453f, 0.0014142135623842478f, 0.00027424818836152554f, 5.3182957344688475e-05f, 1.0313385246263351e-05f};
        float fv = invf[0];
#pragma unroll
        for (int q = 1; q < 8; ++q) fv = (k == q) ? invf[q] : fv;
        const float ang = (float)F.pos[row] * fv;
        double rev = (double)ang * 0.15915494309189535; rev -= __builtin_rint(rev);
        const float fr2 = 2.0f * (float)rev;
        typedef _Float16 h16x2 __attribute__((ext_vector_type(2)));
        h16x2 cs; cs.x = (_Float16)cospif(fr2); cs.y = (_Float16)sinpif(fr2);
        F.ROPE[(size_t)row * 8 + k] = __builtin_bit_cast(unsigned, cs); }
    ln_rows2<4>(F, F.x, F.ln_in_g, F.ln_in_b, F.XN, F.ST0);
}

#define MFMA16(a, b, c) __builtin_amdgcn_mfma_f32_16x16x32_bf16((a), (b), (c), 0, 0, 0)
constexpr int KS_LD = 72, VT_LD = 264;
constexpr int ATT_K_OFF = 0, ATT_V_OFF = 256 * KS_LD * 2;
__device__ __forceinline__ float h_lo(unsigned w) { return (float)__builtin_bit_cast(_Float16, (unsigned short)(w & 0xffffu)); }
__device__ __forceinline__ float h_hi(unsigned w) { return (float)__builtin_bit_cast(_Float16, (unsigned short)(w >> 16)); }
__device__ __forceinline__ v4u rope8(v4u w, v4u pw, v4u t0, v4u t1, float sg) {
    const unsigned tw[8] = {t0.x, t0.y, t0.z, t0.w, t1.x, t1.y, t1.z, t1.w};
    const unsigned ww[4] = {w.x, w.y, w.z, w.w}, pp[4] = {pw.x, pw.y, pw.z, pw.w};
    unsigned o[4];
#pragma unroll
    for (int e = 0; e < 4; ++e) {
        const float ra = bflo(ww[e]) * h_lo(tw[2 * e]) + sg * (bflo(pp[e]) * h_hi(tw[2 * e]));
        const float rb = bfhi(ww[e]) * h_lo(tw[2 * e + 1]) + sg * (bfhi(pp[e]) * h_hi(tw[2 * e + 1]));
        o[e] = pk2(ra, rb);
    }
    return (v4u){o[0], o[1], o[2], o[3]};
}
__device__ __forceinline__ void attn_unit(Frame& F, int unit) {
    const int kh = unit & 1, nb = (unit >> 1) & 31, b = unit >> 6;
    const int R0 = b * SEQ + nb * 128;
    LAS unsigned char* Ks = F.lds + ATT_K_OFF; LAS unsigned char* Vt = F.lds + ATT_V_OFF;
    const int tid = F.tid, lane = F.lane, fr = lane & 15, fq = lane >> 4;
    const int g = F.wave >> 1, qh = kh * 4 + g;
    const v4u Z4 = (v4u){0u, 0u, 0u, 0u};
    v4u qw[4], tq0[4], tq1[4]; bf16x8 q1[4];
#pragma unroll
    for (int rr = 0; rr < 4; ++rr) {
        const int r = (F.wave & 1) * 4 + rr;
        const bf16* qp = F.Qb + (size_t)(R0 + 16 * r + fr) * 512 + qh * 64 + fq * 8;
        qw[rr] = __builtin_nontemporal_load((const v4u*)(qp)); q1[rr] = __builtin_nontemporal_load((const bf16x8*)(qp + 32));
        tq0[rr] = Z4; tq1[rr] = Z4;
        if (fq < 2) { const unsigned* trow = F.ROPE + (size_t)(R0 + 16 * r + fr) * 8; tq0[rr] = *(const v4u*)trow; tq1[rr] = *(const v4u*)(trow + 4); }
    }
    v4u kw[4], kt0[4], kt1[4], vw[4];
#pragma unroll
    for (int i = 0; i < 4; ++i) {
        const int p = tid + 512 * i, key = p >> 3, ch = p & 7;
        const bool valid = (nb > 0 || key >= 128);
        kw[i] = Z4; kt0[i] = Z4; kt1[i] = Z4;
        if (valid) { kw[i] = *(const v4u*)(F.KVb + (size_t)(R0 - 128 + key) * 256 + kh * 64 + ch * 8);
            if (ch < 2) { const unsigned* trow = F.ROPE + (size_t)(R0 - 128 + key) * 8; kt0[i] = *(const v4u*)trow; kt1[i] = *(const v4u*)(trow + 4); } }
        const int keyv = p & 255, chv = p >> 8;
        vw[i] = Z4;
        if (nb > 0 || keyv >= 128) vw[i] = *(const v4u*)(F.KVb + (size_t)(R0 - 128 + keyv) * 256 + 128 + kh * 64 + chv * 8);
    }
#pragma unroll
    for (int i = 0; i < 4; ++i) {
        const int p = tid + 512 * i, key = p >> 3, ch = p & 7;
        v4u w = kw[i];
        v4u pw; pw.x = __shfl_xor(w.x, 1); pw.y = __shfl_xor(w.y, 1); pw.z = __shfl_xor(w.z, 1); pw.w = __shfl_xor(w.w, 1);
        if (ch < 2) w = rope8(w, pw, kt0[i], kt1[i], ch == 0 ? -1.f : 1.f);
        *(LAS v4u*)(Ks + (key * KS_LD + ch * 8) * 2) = w;
    }
#pragma unroll
    for (int i = 0; i < 4; ++i) {
        const int p = tid + 512 * i, key = p & 255, ch = p >> 8;
        const v4u w = vw[i];
        LAS unsigned short* vp = (LAS unsigned short*)(Vt + ((ch * 8) * VT_LD + key) * 2);
        vp[0 * VT_LD] = (unsigned short)(w.x & 0xffffu); vp[1 * VT_LD] = (unsigned short)(w.x >> 16);
        vp[2 * VT_LD] = (unsigned short)(w.y & 0xffffu); vp[3 * VT_LD] = (unsigned short)(w.y >> 16);
        vp[4 * VT_LD] = (unsigned short)(w.z & 0xffffu); vp[5 * VT_LD] = (unsigned short)(w.z >> 16);
        vp[6 * VT_LD] = (unsigned short)(w.w & 0xffffu); vp[7 * VT_LD] = (unsigned short)(w.w >> 16);
    }
    __syncthreads();
    const float sink2 = F.sinks[qh] * LOG2E;
#pragma unroll
    for (int rr = 0; rr < 4; ++rr) {
        const int r = (F.wave & 1) * 4 + rr;
        v4u qv = qw[rr];
        { v4u pw; pw.x = __shfl_xor(qv.x, 16); pw.y = __shfl_xor(qv.y, 16); pw.z = __shfl_xor(qv.z, 16); pw.w = __shfl_xor(qv.w, 16);
          if (fq < 2) qv = rope8(qv, pw, tq0[rr], tq1[rr], fq == 0 ? -1.f : 1.f); }
        const bf16x8 q0 = __builtin_bit_cast(bf16x8, qv);
        f32x4 sa[9];
#pragma unroll
        for (int t = 0; t < 9; ++t) {
            const LAS unsigned char* kp = Ks + ((16 * (r + t) + fr) * KS_LD + fq * 8) * 2;
            f32x4 a = (f32x4){0.f, 0.f, 0.f, 0.f};
            a = MFMA16(*(const LAS bf16x8*)(kp), q0, a);
            a = MFMA16(*(const LAS bf16x8*)(kp + 64), q1[rr], a);
            sa[t] = a;
        }
        float mx = sink2;
#pragma unroll
        for (int t = 0; t < 9; ++t) {
            const bool tile_ok = (nb > 0) || (r + t >= 8);
#pragma unroll
            for (int j = 0; j < 4; ++j) {
                const int diff = 16 * t + 4 * fq + j - fr;
                const bool ok = tile_ok && (diff >= 1) && (diff <= 128);
                const float s = ok ? sa[t][j] : -1e30f;
                sa[t][j] = s; mx = fmaxf(mx, s);
            }
        }
        mx = fmaxf(mx, __shfl_xor(mx, 16)); mx = fmaxf(mx, __shfl_xor(mx, 32));
        float sum = 0.f;
#pragma unroll
        for (int t = 0; t < 9; ++t)
#pragma unroll
            for (int j = 0; j < 4; ++j) { const float p = __builtin_amdgcn_exp2f(sa[t][j] - mx); sa[t][j] = p; sum += p; }
        sum += __shfl_xor(sum, 16); sum += __shfl_xor(sum, 32);
        sum += __builtin_amdgcn_exp2f(sink2 - mx);
        const float inv = 1.0f / sum;
        f32x4 oa[4];
#pragma unroll
        for (int dt = 0; dt < 4; ++dt) oa[dt] = (f32x4){0.f, 0.f, 0.f, 0.f};
#pragma unroll
        for (int kk = 0; kk < 5; ++kk) {
            const int t0 = 2 * kk, t1 = 2 * kk + 1;
            v4u pw; pw.x = pk2(sa[t0][0], sa[t0][1]); pw.y = pk2(sa[t0][2], sa[t0][3]);
            if (t1 < 9) { pw.z = pk2(sa[t1 < 9 ? t1 : 8][0], sa[t1 < 9 ? t1 : 8][1]); pw.w = pk2(sa[t1 < 9 ? t1 : 8][2], sa[t1 < 9 ? t1 : 8][3]); } else { pw.z = 0u; pw.w = 0u; }
            const bf16x8 pf = __builtin_bit_cast(bf16x8, pw);
            const int kc0 = 16 * (r + t0) + 4 * fq, kc1 = (t1 < 9) ? 16 * (r + t1) + 4 * fq : kc0;
#pragma unroll
            for (int dt = 0; dt < 4; ++dt) {
                const LAS unsigned char* vrow = Vt + ((dt * 16 + fr) * VT_LD) * 2;
                const s16x4 lo = *(const LAS s16x4*)(vrow + kc0 * 2), hi = *(const LAS s16x4*)(vrow + kc1 * 2);
                const bf16x8 vf = __builtin_shufflevector(lo, hi, 0, 1, 2, 3, 4, 5, 6, 7);
                oa[dt] = MFMA16(vf, pf, oa[dt]);
            }
        }
        bf16* op = F.CAT + (size_t)(R0 + 16 * r + fr) * 1024 + qh * 64 + 4 * fq;
#pragma unroll
        for (int dt = 0; dt < 4; ++dt) { v2u w; w.x = pk2(oa[dt][0] * inv, oa[dt][1] * inv); w.y = pk2(oa[dt][2] * inv, oa[dt][3] * inv); *(v2u*)(op + dt * 16) = w; }
    }
    __syncthreads();
}

constexpr int SG_LD = 136;
constexpr int SG_ST_OFF = 0, SG_W_OFF = 1024, SG_V_OFF = 1024 + 128 * SG_LD * 2, SG_GB_OFF = SG_V_OFF + 128 * SG_LD * 2;
__device__ __forceinline__ void sgu_unit(Frame& F, int unit) {
    const int R0 = unit * 128;
    LAS float* St = (LAS float*)(F.lds + SG_ST_OFF); LAS unsigned char* Wl = F.lds + SG_W_OFF; LAS unsigned char* Vv = F.lds + SG_V_OFF; LAS float* GB = (LAS float*)(F.lds + SG_GB_OFF);
    const int tid = F.tid, lane = F.lane, fr = lane & 15, fq = lane >> 4, w = F.wave;
    GB[tid] = F.sgu_g[tid]; GB[512 + tid] = F.sgu_b[tid];
    v4u wr_[4], gr_[4];
#define SG_LOAD(h) do { _Pragma("unroll") for (int i = 0; i < 4; ++i) { const int p = tid + 512 * i; \
        wr_[i] = *(const v4u*)(F.Wsb + (size_t)(h) * 16384 + (p >> 4) * 128 + (p & 15) * 8); \
        gr_[i] = *(const v4u*)(F.GV + (size_t)(R0 + (p & 127)) * 512 + (h) * 128 + (p >> 7) * 8); } } while (0)
    SG_LOAD(0);
#pragma unroll 1
    for (int i0 = 0; i0 < 16; i0 += 4) {
        float xv[4][8], s[4], q[4];
#pragma unroll
        for (int k = 0; k < 4; ++k) { const v4u raw = *(const v4u*)(F.GV + (size_t)(R0 + 16 * w + i0 + k) * 512 + lane * 8);
            xv[k][0] = bflo(raw.x); xv[k][1] = bfhi(raw.x); xv[k][2] = bflo(raw.y); xv[k][3] = bfhi(raw.y); xv[k][4] = bflo(raw.z); xv[k][5] = bfhi(raw.z); xv[k][6] = bflo(raw.w); xv[k][7] = bfhi(raw.w); }
#pragma unroll
        for (int k = 0; k < 4; ++k) { s[k] = 0.f;
#pragma unroll
            for (int e = 0; e < 8; ++e) s[k] += xv[k][e]; }
#pragma unroll
        for (int k = 0; k < 4; ++k) s[k] = wave_sum_u(s[k]);
#pragma unroll
        for (int k = 0; k < 4; ++k) { s[k] *= (1.f / 512.f); q[k] = 0.f;
#pragma unroll
            for (int e = 0; e < 8; ++e) { const float d = xv[k][e] - s[k]; q[k] += d * d; } }
#pragma unroll
        for (int k = 0; k < 4; ++k) q[k] = wave_sum_u(q[k]);
        if (lane == 0) {
#pragma unroll
            for (int k = 0; k < 4; ++k) { const int tok = 16 * w + i0 + k; St[2 * tok] = s[k]; St[2 * tok + 1] = 1.f / sqrtf(q[k] * (1.f / 512.f) + LN_EPS); } }
    }
    __syncthreads();
#pragma unroll 1
    for (int h = 0; h < 4; ++h) {
#pragma unroll
        for (int i = 0; i < 4; ++i) { const int p = tid + 512 * i, t = p >> 4, ch = p & 15;
            *(LAS v4u*)(Wl + (t * SG_LD + ch * 8) * 2) = wr_[i]; }
#pragma unroll
        for (int i = 0; i < 4; ++i) { const int p = tid + 512 * i, s = p & 127, cc = p >> 7;
            const v4u raw = gr_[i];
            const float mean = St[2 * s], rstd = St[2 * s + 1];
            const LAS float* gp = GB + h * 128 + cc * 8; const LAS float* bp = GB + 512 + h * 128 + cc * 8;
            const f32x4 g0 = *(const LAS f32x4*)gp, g1 = *(const LAS f32x4*)(gp + 4), b0 = *(const LAS f32x4*)bp, b1 = *(const LAS f32x4*)(bp + 4);
            const float xv[8] = {bflo(raw.x), bfhi(raw.x), bflo(raw.y), bfhi(raw.y), bflo(raw.z), bfhi(raw.z), bflo(raw.w), bfhi(raw.w)};
            const float gg[8] = {g0.x, g0.y, g0.z, g0.w, g1.x, g1.y, g1.z, g1.w}, bb[8] = {b0.x, b0.y, b0.z, b0.w, b1.x, b1.y, b1.z, b1.w};
            LAS unsigned short* vp = (LAS unsigned short*)(Vv + ((cc * 8) * SG_LD + s) * 2);
#pragma unroll
            for (int e = 0; e < 8; e += 2) { const unsigned pw = pk2((xv[e] - mean) * rstd * gg[e] + bb[e], (xv[e + 1] - mean) * rstd * gg[e + 1] + bb[e + 1]);
                vp[e * SG_LD] = (unsigned short)(pw & 0xffffu); vp[(e + 1) * SG_LD] = (unsigned short)(pw >> 16); }
        }
        __syncthreads();
        if (h < 3) SG_LOAD(h + 1);
        const int c4 = h * 128 + 16 * w + 4 * fq;
        v2u gu[8]; float bs[8];
#pragma unroll
        for (int tt = 0; tt < 8; ++tt) { const int tk = 16 * tt + fr; gu[tt] = __builtin_nontemporal_load((const v2u*)(F.GU + (size_t)(R0 + tk) * 512 + c4)); bs[tt] = F.sgu_bias[h * 128 + tk]; }
        f32x4 acc[8];
#pragma unroll
        for (int tt = 0; tt < 8; ++tt) acc[tt] = (f32x4){0.f, 0.f, 0.f, 0.f};
#pragma unroll
        for (int ks = 0; ks < 4; ++ks) {
            const bf16x8 af = *(const LAS bf16x8*)(Vv + ((16 * w + fr) * SG_LD + ks * 32 + fq * 8) * 2);
#pragma unroll
            for (int tt = 0; tt < 8; ++tt) if (tt >= 2 * ks) {
                const bf16x8 bfr = *(const LAS bf16x8*)(Wl + ((16 * tt + fr) * SG_LD + ks * 32 + fq * 8) * 2);
                acc[tt] = MFMA16(af, bfr, acc[tt]);
            }
        }
#pragma unroll
        for (int tt = 0; tt < 8; ++tt) { const int tk = 16 * tt + fr;
            v2u o; o.x = pk2(bflo(gu[tt].x) * (acc[tt][0] + bs[tt]), bfhi(gu[tt].x) * (acc[tt][1] + bs[tt])); o.y = pk2(bflo(gu[tt].y) * (acc[tt][2] + bs[tt]), bfhi(gu[tt].y) * (acc[tt][3] + bs[tt]));
            *(v2u*)(F.CAT + (size_t)(R0 + tk) * 1024 + 512 + c4) = o; }
        __syncthreads();
    }
#undef SG_LOAD
}

struct Args { const void* in[20]; float* out; unsigned char* ws; };
__global__ void __launch_bounds__(NWAVES * 64, 2) hybrid_fwd(Args args) {
    extern __shared__ __attribute__((aligned(16))) unsigned char lds[];
    cg::grid_group grid = cg::this_grid();
    Frame F;
    F.lds = (LAS unsigned char*)lds;
    F.tid = threadIdx.x; F.lane = F.tid & 63; F.wave = __builtin_amdgcn_readfirstlane(F.tid >> 6);
    F.G = gridDim.x; F.bx = blockIdx.x;
    unsigned char* ws = args.ws;
    F.x = (const float*)args.in[0]; F.pos = (const int*)args.in[1]; F.ln_in_g = (const float*)args.in[2]; F.ln_in_b = (const float*)args.in[3];
    F.w_in = (const float*)args.in[4]; F.b_in = (const float*)args.in[5]; F.sinks = (const float*)args.in[6]; F.sgu_g = (const float*)args.in[7]; F.sgu_b = (const float*)args.in[8];
    F.sgu_w = (const float*)args.in[9]; F.sgu_bias = (const float*)args.in[10]; F.w_out = (const float*)args.in[11]; F.b_out = (const float*)args.in[12];
    F.ln_mix_g = (const float*)args.in[13]; F.ln_mix_b = (const float*)args.in[14]; F.w_gate = (const float*)args.in[15]; F.w_up = (const float*)args.in[16]; F.w_down = (const float*)args.in[17];
    F.ln_ffn_g = (const float*)args.in[18]; F.ln_ffn_b = (const float*)args.in[19]; F.out = args.out;
    F.WinT = (bf16*)(ws + WS_WIN); F.WoT = (bf16*)(ws + WS_WO); F.WguT = (bf16*)(ws + WS_WGU); F.WdT = (bf16*)(ws + WS_WD); F.Wsb = (bf16*)(ws + WS_WS);
    F.ST0 = (float*)(ws + WS_ST0); F.ROPE = (unsigned*)(ws + WS_ROPE); F.MIX = (bf16*)(ws + WS_MIX); F.FFN = (bf16*)(ws + WS_FFN);
    F.XN = (bf16*)(ws + WS_XN); F.Qb = (bf16*)(ws + WS_Q); F.KVb = (bf16*)(ws + WS_KV); F.GU = (bf16*)(ws + WS_GU); F.GV = (bf16*)(ws + WS_GV);
    F.CAT = (bf16*)(ws + WS_CAT); F.ACT = (bf16*)(ws + WS_ACT);

    volatile LAS unsigned* bst = (volatile LAS unsigned*)(F.lds + LDS_BYTES - 64);
    if (F.tid < 16) bst[F.tid] = 0u;
    unsigned* barw = (unsigned*)(ws + WS_BAR);
    __syncthreads();
    XcdBarrier bar = xcd_barrier_post(barw, bst);
    if (args.ws == nullptr) grid.sync();
    p0_prologue(F);
#define GRID_BAR() xcd_barrier(bar)
    GRID_BAR();
    { pg8::Gemm g{F.XN, F.WinT, M, NIN, D}; pg8::StaticOrder S; S.init(M, NIN, F.G, F.bx);
      pg8::EpiIn E{F.Qb, F.KVb, F.GU, F.GV, F.b_in, QSCALE};
      pg8::gemm_phase<pg8::EpiIn, pg8::StaticOrder, true, true>(F.lds, g, S, E); }
    p1_tail_transposes(F);
    GRID_BAR();
    for (int u = F.bx; u < BATCH * 32; u += F.G) sgu_unit(F, u);
    for (int u = F.bx; u < BATCH * 32 * 2; u += F.G) attn_unit(F, u);
    GRID_BAR();
    { pg8::Gemm g{F.CAT, F.WoT, M, D, D}; pg8::StaticOrder S; S.init(M, D, F.G, F.bx);
      pg8::EpiPlainBf16 E{F.MIX, D, F.b_out};
      pg8::gemm_phase<pg8::EpiPlainBf16, pg8::StaticOrder, false, true>(F.lds, g, S, E); }
    GRID_BAR();
    chain_rows2<2, 2>(F, F.MIX, nullptr, F.XN, nullptr);
    GRID_BAR();
    { pg8::Gemm g{F.XN, F.WguT, M, NGU, D}; pg8::StaticOrder S; S.init(M, NGU, F.G, F.bx);
      pg8::EpiSwiglu E{F.ACT, DFF};
      pg8::gemm_phase<pg8::EpiSwiglu, pg8::StaticOrder, false, true>(F.lds, g, S, E); }
    GRID_BAR();
    { pg8::Gemm g{F.ACT, F.WdT, M, D, DFF}; pg8::StaticOrder S; S.init(M, D, F.G, F.bx);
      pg8::EpiPlainBf16 E{F.FFN, D, nullptr};
      pg8::gemm_phase<pg8::EpiPlainBf16, pg8::StaticOrder, false, true>(F.lds, g, S, E); }
    GRID_BAR();
    chain_rows2<3, 2>(F, F.MIX, F.FFN, nullptr, F.out);
}

extern "C" void kernel_launch(void* const* d_in, const int* in_sizes, int n_in, void* d_out, int out_size, void* d_ws, size_t ws_size, hipStream_t stream) {
    static int grid = 0;
    if (grid == 0) {
        if (n_in != 20 || in_sizes[0] != M * D || out_size != M * D || ws_size < WS_END) { fprintf(stderr, "kernel_launch: unexpected shapes (n_in %d, in0 %d, out %d, ws %zu)\n", n_in, n_in > 0 ? in_sizes[0] : -1, out_size, ws_size); grid = -1; return; }
        int dev = 0, cus = 0, per_cu = 0;
        (void)hipGetDevice(&dev); (void)hipDeviceGetAttribute(&cus, hipDeviceAttributeMultiprocessorCount, dev);
        if (hipFuncSetAttribute((const void*)hybrid_fwd, hipFuncAttributeMaxDynamicSharedMemorySize, LDS_BYTES) != hipSuccess) { fprintf(stderr, "kernel_launch: hipFuncSetAttribute failed\n"); grid = -1; return; }
        if (hipOccupancyMaxActiveBlocksPerMultiprocessor(&per_cu, (const void*)hybrid_fwd, NWAVES * 64, LDS_BYTES) != hipSuccess || per_cu < 1) { fprintf(stderr, "kernel_launch: occupancy query says %d\n", per_cu); per_cu = 1; }
        (void)hipGetLastError();
        grid = cus * per_cu;
    }
    if (grid < 0) return;
    Args a{};
    for (int i = 0; i < 20; ++i) a.in[i] = d_in[i];
    a.out = (float*)d_out; a.ws = (unsigned char*)d_ws;
    if (hipMemsetAsync((char*)d_ws + WS_BAR, 0, 16384, stream) != hipSuccess) { fprintf(stderr, "kernel_launch: memset failed\n"); return; }
    void* kargs[] = {&a};
    const hipError_t e = hipLaunchCooperativeKernel((const void*)hybrid_fwd, dim3(grid), dim3(NWAVES * 64), kargs, LDS_BYTES, stream);
    if (e != hipSuccess) fprintf(stderr, "kernel_launch: cooperative launch failed: %s (grid %d)\n", hipGetErrorString(e), grid);
}
```

```cpp
#include <hip/hip_runtime.h>
#include <hip/hip_cooperative_groups.h>
#include <cstdio>
#include <cstdint>
namespace cg = cooperative_groups;
namespace pg8 {
#define PG8_LAS __attribute__((address_space(3)))
typedef unsigned short bf16_t;
typedef short bf16x8 __attribute__((ext_vector_type(8)));
typedef float f32x4 __attribute__((ext_vector_type(4)));
typedef unsigned u32x4 __attribute__((ext_vector_type(4)));
constexpr int BM = 256, BK = 64, HALF = 128, HTB = HALF * BK * 2  , STAGE_BYTES = 8 * HTB, NXCD = 8, WGM = 8;

__host__ __device__ __forceinline__ int lds_byte(int r, int c) { const int st = (r >> 4) * 2 + (c >> 5), rr = r & 15, cc = c & 31, ob = rr * 64 + cc * 2; return st * 1024 + (ob ^ (((ob >> 9) & 1) << 5)); }
__host__ __device__ __forceinline__ void stage_rc(int b, int& R, int& C) { const int st = b / 1024, sb = b % 1024, swz = sb ^ (((sb >> 9) & 1) << 5); R = (st >> 1) * 16 + swz / 64; C = (st & 1) * 32 + (swz % 64) / 2; }
__host__ __device__ __forceinline__ int perm32(int rho) { const int n = rho >> 4, i = rho & 15; return 8 * (i >> 2) + 4 * n + (i & 3); }

struct Unit { int pm, pn; };
struct Gemm { const bf16_t* A; const bf16_t* Bt; int M, N, K; };

struct StaticOrder {
    int nM, nN, nwg, G, c;
    __host__ __device__ void init(int M, int N, int G_, int c_) { nM = M / BM; nN = N / BM; nwg = nM * nN; G = G_; c = c_; }
    __host__ __device__ bool next(int i, Unit& u) const {
        const long L = (long)i * G + c; if (L >= nwg) return false;
        int wgid = (int)L; { const int q = nwg / NXCD, r = nwg % NXCD, xcd = wgid % NXCD, off = wgid / NXCD; wgid = (xcd < r ? xcd * (q + 1) : r * (q + 1) + (xcd - r) * q) + off; }
        const int nig = WGM * nN, gid = wgid / nig, fm = gid * WGM, gsz = (nM - fm) < WGM ? (nM - fm) : WGM;
        u.pm = fm + ((wgid % nig) % gsz); u.pn = (wgid % nig) / gsz; return true;
    }
    __device__ __forceinline__ void a_ready(const Unit&) const {}
    __device__ __forceinline__ void done(const Unit&) const {}
};

__device__ __forceinline__ unsigned cvt_pk_bf16(float lo, float hi) { unsigned r; asm volatile("v_cvt_pk_bf16_f32 %0, %1, %2" : "=v"(r) : "v"(lo), "v"(hi)); return r; }
typedef float f32x2 __attribute__((ext_vector_type(2)));
__device__ __forceinline__ f32x2 gelu_pk(f32x2 v) {
    const f32x2 av = __builtin_elementwise_abs(v), d = av * 0.2316418882f + 1.0f;
    f32x2 t; t.x = __builtin_amdgcn_rcpf(d.x); t.y = __builtin_amdgcn_rcpf(d.y);
    f32x2 q = t * 0.5307027145f + (-0.7265760135f); q = q * t + 0.7107068705f; q = q * t + (-0.142248368f); q = q * t + 0.127414796f; q = q * t;
    const f32x2 s = (v * v) * (-0.72134752044f);
    f32x2 e; e.x = __builtin_amdgcn_exp2f(s.x); e.y = __builtin_amdgcn_exp2f(s.y);
    const f32x2 m = v * (q * e), r = v - m;
    f32x2 o; o.x = v.x < 0.f ? m.x : r.x; o.y = v.y < 0.f ? m.y : r.y; return o;
}
typedef unsigned u32x2 __attribute__((ext_vector_type(2)));
struct EpiIn {
    static constexpr bool PERM = true, AFTER_DRAIN = false;
    bf16_t* Qb; bf16_t* KVb; bf16_t* GU; bf16_t* GV; const float* bias; float qscale;
    __device__ __forceinline__ void operator()(const f32x4 (&acc)[2][2][4][2], const Unit& u, int wr, int wc, int fr, int fq) const {
        const int rowu = u.pm * BM + wr * 64;
#pragma unroll
        for (int bj = 0; bj < 2; ++bj) {
            const int colu = u.pn * BM + bj * HALF + wc * 32;
            const int ctile = u.pn * 2 + bj;
            bf16_t* base; int ld; int coff; int kind;
            if (ctile < 4) { base = Qb; ld = 512; coff = colu; kind = 0; }
            else if (ctile < 6) { base = KVb; ld = 256; coff = colu - 512; kind = 1; }
            else if (ctile < 10) { base = GU; ld = 512; coff = colu - 768; kind = 3; }
            else { base = GV; ld = 512; coff = colu - 1280; kind = 3; }
            char* ob = (char*)base + ((size_t)rowu * ld + coff) * 2;
            const unsigned voff = (unsigned)(fr * ld * 2 + fq * 16);
            const char* bb = (const char*)bias + (size_t)colu * 4;
            const f32x4 bv0 = *(const f32x4*)(bb + fq * 32), bv1 = *(const f32x4*)(bb + fq * 32 + 16);
#pragma unroll
            for (int ai = 0; ai < 2; ++ai)
#pragma unroll
                for (int m = 0; m < 4; ++m) {
                    f32x4 v0 = acc[ai][bj][m][0] + bv0, v1 = acc[ai][bj][m][1] + bv1;
                    if (kind == 0) { v0 = v0 * qscale; v1 = v1 * qscale; }
                    if (kind == 3) { f32x2 a = gelu_pk((f32x2){v0[0], v0[1]}), b = gelu_pk((f32x2){v0[2], v0[3]}), c = gelu_pk((f32x2){v1[0], v1[1]}), d = gelu_pk((f32x2){v1[2], v1[3]});
                        v0 = (f32x4){a.x, a.y, b.x, b.y}; v1 = (f32x4){c.x, c.y, d.x, d.y}; }
                    u32x4 w; w.x = cvt_pk_bf16(v0[0], v0[1]); w.y = cvt_pk_bf16(v0[2], v0[3]); w.z = cvt_pk_bf16(v1[0], v1[1]); w.w = cvt_pk_bf16(v1[2], v1[3]);
                    *(u32x4*)(ob + (size_t)(ai * HALF + m * 16) * ld * 2 + voff) = w;
                }
        }
    }
};
struct EpiRes {
    static constexpr bool PERM = true, AFTER_DRAIN = false;
    const float* src; const float* stats; const float* g; const float* b; const float* bias; float* out; float alpha;
    __device__ __forceinline__ void operator()(const f32x4 (&acc)[2][2][4][2], const Unit& u, int wr, int wc, int fr, int fq) const {
        const unsigned voff = (unsigned)(fr * 4096 + fq * 32), voffs = (unsigned)(fr * 8), voffc = (unsigned)(fq * 32);
        const size_t ubase = ((size_t)(u.pm * BM + wr * 64) * 1024 + (size_t)(u.pn * BM + wc * 32)) * 4;
        const char* sb = (const char*)src + ubase; char* ob = (char*)out + ubase;
        const char* stb = (const char*)stats + (size_t)(u.pm * BM + wr * 64) * 8;
        const size_t cbase = (size_t)(u.pn * BM + wc * 32) * 4;
#pragma unroll
        for (int bj = 0; bj < 2; ++bj) {
            const char* gp = (const char*)g + cbase + bj * HALF * 4; const char* bp = (const char*)b + cbase + bj * HALF * 4;
            f32x4 g0 = *(const f32x4*)(gp + voffc) * alpha, g1 = *(const f32x4*)(gp + voffc + 16) * alpha;
            f32x4 b0 = *(const f32x4*)(bp + voffc) * alpha, b1 = *(const f32x4*)(bp + voffc + 16) * alpha;
            if (bias) { const char* bb = (const char*)bias + cbase + bj * HALF * 4; b0 += *(const f32x4*)(bb + voffc); b1 += *(const f32x4*)(bb + voffc + 16); }
#pragma unroll
            for (int ai = 0; ai < 2; ++ai) {
                f32x4 xa[4][2]; f32x2 sa[4];
#pragma unroll
                for (int m = 0; m < 4; ++m) { const size_t ro = ((size_t)(ai * HALF + m * 16) * 1024 + bj * HALF) * 4;
                    sa[m] = *(const f32x2*)(stb + (size_t)(ai * HALF + m * 16) * 8 + voffs); xa[m][0] = *(const f32x4*)(sb + ro + voff); xa[m][1] = *(const f32x4*)(sb + ro + voff + 16); }
#pragma unroll
                for (int m = 0; m < 4; ++m) { const size_t ro = ((size_t)(ai * HALF + m * 16) * 1024 + bj * HALF) * 4;
                    const f32x2 st = sa[m];
                    const f32x4 y0 = ((xa[m][0] - st.x) * st.y) * g0 + b0 + acc[ai][bj][m][0];
                    const f32x4 y1 = ((xa[m][1] - st.x) * st.y) * g1 + b1 + acc[ai][bj][m][1];
                    *(f32x4*)(ob + ro + voff) = y0; *(f32x4*)(ob + ro + voff + 16) = y1;
                }
            }
        }
    }
};
struct EpiSwiglu {
    static constexpr bool PERM = true, AFTER_DRAIN = false;
    bf16_t* O; int ldo;
    __device__ __forceinline__ void operator()(const f32x4 (&acc)[2][2][4][2], const Unit& u, int wr, int wc, int fr, int fq) const {
        char* ob = (char*)O + ((size_t)(u.pm * BM + wr * 64) * ldo + u.pn * 128 + wc * 32) * 2;
        const unsigned voff = (unsigned)(fr * ldo * 2 + fq * 16);
#pragma unroll
        for (int ai = 0; ai < 2; ++ai)
#pragma unroll
            for (int m = 0; m < 4; ++m) {
                float a[8];
#pragma unroll
                for (int n = 0; n < 2; ++n)
#pragma unroll
                    for (int e = 0; e < 4; ++e) { const float gt = acc[ai][0][m][n][e], up = acc[ai][1][m][n][e];
                        const float ex = __builtin_amdgcn_exp2f(gt * -1.44269504089f); a[4 * n + e] = gt * __builtin_amdgcn_rcpf(1.0f + ex) * up; }
                u32x4 w; w.x = cvt_pk_bf16(a[0], a[1]); w.y = cvt_pk_bf16(a[2], a[3]); w.z = cvt_pk_bf16(a[4], a[5]); w.w = cvt_pk_bf16(a[6], a[7]);
                __builtin_nontemporal_store(w, (u32x4*)(ob + (size_t)(ai * HALF + m * 16) * ldo * 2 + voff));
            }
    }
};
struct EpiPlainBf16 {
    static constexpr bool PERM = true, AFTER_DRAIN = false;
    bf16_t* O; int ldo; const float* bias;
    __device__ __forceinline__ void operator()(const f32x4 (&acc)[2][2][4][2], const Unit& u, int wr, int wc, int fr, int fq) const {
        char* ob = (char*)O + ((size_t)(u.pm * BM + wr * 64) * ldo + u.pn * BM + wc * 32) * 2;
        const unsigned voff = (unsigned)(fr * ldo * 2 + fq * 16);
#pragma unroll
        for (int bj = 0; bj < 2; ++bj) {
            f32x4 bv0 = (f32x4){0.f, 0.f, 0.f, 0.f}, bv1 = bv0;
            if (bias) { const char* bb = (const char*)bias + (size_t)(u.pn * BM + bj * HALF + wc * 32) * 4; bv0 = *(const f32x4*)(bb + fq * 32); bv1 = *(const f32x4*)(bb + fq * 32 + 16); }
#pragma unroll
            for (int ai = 0; ai < 2; ++ai)
#pragma unroll
                for (int m = 0; m < 4; ++m) {
                    const f32x4 v0 = acc[ai][bj][m][0] + bv0, v1 = acc[ai][bj][m][1] + bv1;
                    u32x4 w; w.x = cvt_pk_bf16(v0[0], v0[1]); w.y = cvt_pk_bf16(v0[2], v0[3]); w.z = cvt_pk_bf16(v1[0], v1[1]); w.w = cvt_pk_bf16(v1[2], v1[3]);
                    *(u32x4*)(ob + ((size_t)(ai * HALF + m * 16) * ldo + bj * HALF) * 2 + voff) = w;
                }
        }
    }
};
template <class Epi, class Sched, bool ALIGN_EPI = false, bool SP2 = false>
__device__ __forceinline__ void gemm_phase(PG8_LAS unsigned char* lds, const Gemm g, const Sched& S, const Epi& E) {
    int tid_ = threadIdx.x; asm volatile("" : "+v"(tid_));
    const int tid = tid_, wid = __builtin_amdgcn_readfirstlane(tid >> 6), lane = tid & 63, wr = wid >> 2, wc = wid & 3, fr = lane & 15, fq = lane >> 4;
    const int K = g.K, nt = K / BK;
    unsigned voffA[2], voffB[2];
#pragma unroll
    for (int i = 0; i < 2; ++i) { int R, C; stage_rc(tid * 16 + i * 8192, R, C); const int Rb = Epi::PERM ? ((R & ~31) + perm32(R & 31)) : R;
        voffA[i] = (unsigned)(R * K + C) * 2u; voffB[i] = (unsigned)(Rb * K + C) * 2u; }
    const size_t kstep = (size_t)(BK * 2);
    const size_t hstep = (size_t)HALF * K * 2;
    const size_t tstep = 2 * hstep;
    const unsigned ldsw = (unsigned)wid * 1024u;
    const int aoff = lds_byte(wr * 64 + fr, fq * 8), boff = lds_byte(wc * 32 + fr, fq * 8);
#define PG8_SA(b, h) (((b) * 2 + (h)) * HTB)
#define PG8_SB(b, h) ((4 + (b) * 2 + (h)) * HTB)
#define PG8_STAGE(bufoff, gbase, voff) do { _Pragma("unroll") for (int _i = 0; _i < 2; ++_i) \
        __builtin_amdgcn_global_load_lds((const unsigned*)((const char*)(gbase) + (voff)[_i]), (PG8_LAS unsigned*)(lds + (bufoff) + ldsw + _i * 8192), 16, 0, 0); } while (0)
#define PG8_LDA(dst, b, h) do { _Pragma("unroll") for (int m = 0; m < 4; ++m) _Pragma("unroll") for (int k = 0; k < 2; ++k) dst[m][k] = *(const PG8_LAS bf16x8*)(lds + PG8_SA(b, h) + aoff + m * 2048 + k * 1024); } while (0)
#define PG8_LDB(dst, b, h) do { _Pragma("unroll") for (int n = 0; n < 2; ++n) _Pragma("unroll") for (int k = 0; k < 2; ++k) dst[n][k] = *(const PG8_LAS bf16x8*)(lds + PG8_SB(b, h) + boff + n * 2048 + k * 1024); } while (0)
#define PG8_MMA(ai, bj, At, Bt) do { __builtin_amdgcn_s_setprio(1); _Pragma("unroll") for (int m = 0; m < 4; ++m) _Pragma("unroll") for (int n = 0; n < 2; ++n) _Pragma("unroll") for (int k = 0; k < 2; ++k) \
        acc[ai][bj][m][n] = __builtin_amdgcn_mfma_f32_16x16x32_bf16(Bt[n][k], At[m][k], acc[ai][bj][m][n], 0, 0, 0); __builtin_amdgcn_s_setprio(0); } while (0)
#define PG8_WAIT_V(n) asm volatile("s_waitcnt vmcnt(" #n ")" ::: "memory")
#define PG8_WAIT_L(n) asm volatile("s_waitcnt lgkmcnt(" #n ")" ::: "memory")
#define PG8_BAR __builtin_amdgcn_s_barrier()
#define PG8_SCHED __builtin_amdgcn_sched_barrier(0)
    Unit cur, nxt; int ui = 0;
    if (!S.next(0, cur)) return;
    f32x4 acc[2][2][4][2];
#pragma unroll
    for (int a = 0; a < 2; ++a)
#pragma unroll
        for (int b = 0; b < 2; ++b)
#pragma unroll
            for (int m = 0; m < 4; ++m)
#pragma unroll
                for (int n = 0; n < 2; ++n) acc[a][b][m][n] = (f32x4){0.f, 0.f, 0.f, 0.f};
    bf16x8 At[4][2], B0[2][2], B1[2][2];
    const char* cA = (const char*)g.A + (size_t)cur.pm * tstep; const char* cB = (const char*)g.Bt + (size_t)cur.pn * tstep;
    S.a_ready(cur);
    if constexpr (SP2) {
        PG8_STAGE(PG8_SB(0, 0), cB, voffB); PG8_STAGE(PG8_SB(0, 1), cB + hstep, voffB); PG8_STAGE(PG8_SA(0, 0), cA, voffA); PG8_STAGE(PG8_SA(0, 1), cA + hstep, voffA);
        if (wr == 1) PG8_BAR;
        PG8_WAIT_V(2); PG8_BAR;
        PG8_STAGE(PG8_SB(1, 0), cB + kstep, voffB); PG8_STAGE(PG8_SA(1, 0), cA + kstep, voffA); PG8_STAGE(PG8_SB(1, 1), cB + hstep + kstep, voffB);
        PG8_WAIT_V(6); PG8_BAR;
    } else {
        PG8_STAGE(PG8_SB(0, 0), cB, voffB); PG8_STAGE(PG8_SA(0, 0), cA, voffA); PG8_STAGE(PG8_SB(0, 1), cB + hstep, voffB); PG8_STAGE(PG8_SA(0, 1), cA + hstep, voffA);
        if (wr == 1) PG8_BAR;
        PG8_WAIT_V(4); PG8_BAR;
        PG8_STAGE(PG8_SB(1, 0), cB + kstep, voffB); PG8_STAGE(PG8_SA(1, 0), cA + kstep, voffA); PG8_STAGE(PG8_SB(1, 1), cB + hstep + kstep, voffB);
        PG8_WAIT_V(6); PG8_BAR;
    }
    for (;;) {
        const bool has_next = S.next(ui + 1, nxt);
        const char* nA = has_next ? (const char*)g.A + (size_t)nxt.pm * tstep : cA; const char* nB = has_next ? (const char*)g.Bt + (size_t)nxt.pn * tstep : cB;
        for (int t = 0; t < nt; t += 2) {
            const bool last = (t == nt - 2);
            const char* a1 = cA + (size_t)(t + 1) * kstep;
            const char* a2 = last ? nA : cA + (size_t)(t + 2) * kstep; const char* b2 = last ? nB : cB + (size_t)(t + 2) * kstep;
            const char* a3 = a2 + kstep; const char* b3 = b2 + kstep;
            if (last && has_next) S.a_ready(nxt);
            if constexpr (SP2) {
            PG8_LDB(B0, 0, 0); PG8_LDB(B1, 0, 1); PG8_SCHED; PG8_LDA(At, 0, 0); PG8_STAGE(PG8_SA(1, 1), a1 + hstep, voffA);
            PG8_WAIT_V(8); PG8_WAIT_L(0); PG8_BAR; PG8_MMA(0, 0, At, B0); PG8_MMA(0, 1, At, B1); PG8_BAR; PG8_SCHED;
            PG8_LDA(At, 0, 1); PG8_STAGE(PG8_SB(0, 0), b2, voffB); PG8_STAGE(PG8_SB(0, 1), b2 + hstep, voffB); PG8_STAGE(PG8_SA(0, 0), a2, voffA);
            PG8_WAIT_V(8); PG8_WAIT_L(0); PG8_BAR; PG8_MMA(1, 0, At, B0); PG8_MMA(1, 1, At, B1); PG8_BAR; PG8_SCHED;
            PG8_LDB(B0, 1, 0); PG8_LDB(B1, 1, 1); PG8_SCHED; PG8_LDA(At, 1, 0); PG8_STAGE(PG8_SA(0, 1), a2 + hstep, voffA);
            PG8_WAIT_V(8); PG8_WAIT_L(0); PG8_BAR; PG8_MMA(0, 0, At, B0); PG8_MMA(0, 1, At, B1); PG8_BAR; PG8_SCHED;
            PG8_LDA(At, 1, 1); PG8_STAGE(PG8_SB(1, 0), b3, voffB); PG8_STAGE(PG8_SB(1, 1), b3 + hstep, voffB); PG8_STAGE(PG8_SA(1, 0), a3, voffA);
            PG8_WAIT_V(8); PG8_WAIT_L(0); PG8_BAR; PG8_MMA(1, 0, At, B0); PG8_MMA(1, 1, At, B1); PG8_BAR; PG8_SCHED;
            } else {
            PG8_LDB(B0, 0, 0); PG8_SCHED; PG8_LDA(At, 0, 0); PG8_STAGE(PG8_SA(1, 1), a1 + hstep, voffA);
            PG8_WAIT_L(8); PG8_BAR; PG8_WAIT_L(0); PG8_MMA(0, 0, At, B0); PG8_BAR; PG8_SCHED;
            PG8_LDB(B1, 0, 1); PG8_STAGE(PG8_SB(0, 0), b2, voffB);
            PG8_BAR; PG8_WAIT_L(0); PG8_MMA(0, 1, At, B1); PG8_BAR;
            PG8_LDA(At, 0, 1); PG8_STAGE(PG8_SA(0, 0), a2, voffA);
            PG8_BAR; PG8_WAIT_L(0); PG8_MMA(1, 0, At, B0); PG8_BAR; PG8_SCHED;
            PG8_STAGE(PG8_SB(0, 1), b2 + hstep, voffB);
            PG8_WAIT_V(6); PG8_BAR; PG8_MMA(1, 1, At, B1); PG8_BAR;
            PG8_LDB(B0, 1, 0); PG8_SCHED; PG8_LDA(At, 1, 0); PG8_STAGE(PG8_SA(0, 1), a2 + hstep, voffA);
            PG8_WAIT_L(8); PG8_BAR; PG8_WAIT_L(0); PG8_MMA(0, 0, At, B0); PG8_BAR; PG8_SCHED;
            PG8_LDB(B1, 1, 1); PG8_STAGE(PG8_SB(1, 0), b3, voffB);
            PG8_BAR; PG8_WAIT_L(0); PG8_MMA(0, 1, At, B1); PG8_BAR;
            PG8_LDA(At, 1, 1); PG8_STAGE(PG8_SA(1, 0), a3, voffA);
            PG8_BAR; PG8_WAIT_L(0); PG8_MMA(1, 0, At, B0); PG8_BAR; PG8_SCHED;
            PG8_STAGE(PG8_SB(1, 1), b3 + hstep, voffB);
            PG8_WAIT_V(6); PG8_BAR; PG8_MMA(1, 1, At, B1); PG8_BAR;
            }
        }
        if constexpr (ALIGN_EPI) { if (wr == 0) PG8_BAR; }
        if constexpr (!Epi::AFTER_DRAIN) { E(acc, cur, wr, wc, fr, fq); S.done(cur); }
        if (!has_next) break;
#pragma unroll
        for (int a = 0; a < 2; ++a)
#pragma unroll
            for (int b = 0; b < 2; ++b)
#pragma unroll
                for (int m = 0; m < 4; ++m)
#pragma unroll
                    for (int n = 0; n < 2; ++n) acc[a][b][m][n] = (f32x4){0.f, 0.f, 0.f, 0.f};
        cur = nxt; cA = nA; cB = nB; ++ui;
        if constexpr (ALIGN_EPI) { if (wr == 1) PG8_BAR; }
    }
    PG8_WAIT_V(0);
    if constexpr (!ALIGN_EPI) { if (wr == 0) PG8_BAR; }
    PG8_BAR;
    if constexpr (Epi::AFTER_DRAIN) { E.fused(acc, cur, wr, wc, fr, fq, lds, wid, lane); S.done(cur); }
#undef PG8_SA
#undef PG8_SB
#undef PG8_STAGE
#undef PG8_LDA
#undef PG8_LDB
#undef PG8_MMA
#undef PG8_WAIT_V
#undef PG8_WAIT_L
#undef PG8_BAR
#undef PG8_SCHED
}
}

constexpr int NWAVES = 8;
constexpr int BATCH = 8, SEQ = 4096, D = 1024, M = BATCH * SEQ;
constexpr int NIN = 1792, DFF = 2816, NGU = 2 * DFF;
constexpr float LN_EPS = 1e-5f;
constexpr float ALPHA = 1.189207115002721f;
constexpr float QSCALE = 0.125f * 1.44269504089f;
constexpr float LOG2E = 1.44269504089f;
constexpr size_t MiB = 1u << 20;
constexpr size_t WS_BAR = 0;
constexpr size_t WS_WIN = 1 * MiB, WS_WO = 5 * MiB, WS_WGU = 7 * MiB, WS_WD = 18 * MiB;
constexpr size_t WS_WS = 24 * MiB, WS_ST0 = 24 * MiB + 512 * 1024, WS_ST1 = 24 * MiB + 768 * 1024, WS_ROPE = 25 * MiB;
constexpr size_t WS_XN = 32 * MiB;
constexpr size_t WS_MIX = 96 * MiB;
constexpr size_t WS_FFN = 160 * MiB;
constexpr size_t WS_Q = 224 * MiB, WS_KV = 256 * MiB, WS_GU = 272 * MiB, WS_GV = 304 * MiB, WS_CAT = 336 * MiB;
constexpr size_t WS_ACT = 224 * MiB;
constexpr size_t WS_END = 400 * MiB;
static_assert(WS_ACT + (size_t)M * DFF * 2 <= WS_END && WS_CAT + (size_t)M * D * 2 <= WS_END, "ws map");
constexpr int LDS_BYTES = 147456;

#define GAS __attribute__((address_space(1)))
#define LAS __attribute__((address_space(3)))
typedef unsigned short bf16;
typedef unsigned v4u __attribute__((ext_vector_type(4)));
typedef unsigned v2u __attribute__((ext_vector_type(2)));
typedef float f32x4 __attribute__((ext_vector_type(4)));
typedef float f32x2 __attribute__((ext_vector_type(2)));
typedef short bf16x8 __attribute__((ext_vector_type(8)));
typedef short s16x4 __attribute__((ext_vector_type(4)));
#define RLX_AGENT __ATOMIC_RELAXED, __HIP_MEMORY_SCOPE_AGENT
#define LDS_WAIT() asm volatile("s_waitcnt lgkmcnt(0)" ::: "memory")
__device__ __forceinline__ unsigned pk2(float lo, float hi) { return pg8::cvt_pk_bf16(lo, hi); }
__device__ __forceinline__ float bflo(unsigned w) { return __builtin_bit_cast(float, w << 16); }
__device__ __forceinline__ float bfhi(unsigned w) { return __builtin_bit_cast(float, w & 0xffff0000u); }
template <int CTRL, int ROWMASK> __device__ __forceinline__ float dpp_add(float v) {
    return v + __builtin_bit_cast(float, __builtin_amdgcn_update_dpp(0, __builtin_bit_cast(int, v), CTRL, ROWMASK, 0xf, false));
}
__device__ __forceinline__ float wave_sum_u(float v) {
    v = dpp_add<0xB1, 0xf>(v); v = dpp_add<0x4E, 0xf>(v); v = dpp_add<0x141, 0xf>(v); v = dpp_add<0x140, 0xf>(v);
    v = dpp_add<0x142, 0xa>(v); v = dpp_add<0x143, 0xc>(v);
    return __builtin_bit_cast(float, __builtin_amdgcn_readlane(__builtin_bit_cast(int, v), 63));
}
__device__ __forceinline__ float wave_sum(float v) {
#pragma unroll
    for (int o = 1; o < 64; o <<= 1) v += __shfl_xor(v, o);
    return v;
}

#define XB_TMO      128
#define XB_XCNT(j)  (256  + 64 * (j))
#define XB_XSUB(j)  (1280 + 64 * (j))
#define XB_XGEN(j)  (2304 + 64 * (j))
#define XB_TOP      3328
#define XB_TOPGEN   3392
#define XCD_BAR_WORDS 3456
#define XB_SPIN_CAP (1u << 18)

__device__ __forceinline__ unsigned xb_ld(unsigned* p)              { return __hip_atomic_load(p, __ATOMIC_RELAXED, __HIP_MEMORY_SCOPE_AGENT); }
__device__ __forceinline__ unsigned xb_add(unsigned* p, unsigned v) { return __hip_atomic_fetch_add(p, v, __ATOMIC_RELAXED, __HIP_MEMORY_SCOPE_AGENT); }
__device__ __forceinline__ unsigned xb_xcc_id() { return (unsigned)__builtin_amdgcn_s_getreg((3 << 11) | 20) & 0xFu; }
#define XB_SPIN(cond, bar) do { unsigned _sp = 0; while (cond) { __builtin_amdgcn_s_sleep(1); \
    if ((++_sp & 255u) == 0u) { if (xb_ld(&(bar)[XB_TMO])) break; if (_sp > XB_SPIN_CAP) { atomicAdd(&(bar)[XB_TMO], 1u); break; } } } } while (0)

struct XcdBarrier {
    unsigned* bar; unsigned x;
    volatile LAS unsigned* st;
};

__device__ __forceinline__ XcdBarrier xcd_barrier_post(unsigned* bar, volatile LAS unsigned* st) {
    XcdBarrier b; b.bar = bar; b.x = xb_xcc_id(); b.st = st;
    if (threadIdx.x == 0) (void)xb_add(&bar[XB_XCNT(b.x)], 1u);
    return b;
}
__device__ __forceinline__ void xcd_barrier_complete(unsigned* bar, unsigned x, unsigned& nloc, unsigned& nx) {
    const unsigned G = gridDim.x * gridDim.y * gridDim.z;
    unsigned sum, cnt, mine, sp = 0u;
    for (;;) {
        sum = 0u; cnt = 0u; mine = 0u;
#pragma unroll
        for (unsigned j = 0; j < 16; ++j) { const unsigned c = xb_ld(&bar[XB_XCNT(j)]); sum += c; cnt += (c > 0u) ? 1u : 0u; mine = (j == x) ? c : mine; }
        if (sum == G) break;
        __builtin_amdgcn_s_sleep(1);
        if ((++sp & 255u) == 0u) { if (xb_ld(&bar[XB_TMO])) break; if (sp > XB_SPIN_CAP) { atomicAdd(&bar[XB_TMO], 1u); break; } }
    }
    nloc = mine > 0u ? mine : 1u; nx = cnt > 0u ? cnt : 1u;
}

__device__ __forceinline__ void xcd_barrier(const XcdBarrier& b) {
    asm volatile("s_waitcnt vmcnt(0)" ::: "memory");
    __syncthreads();
    if (threadIdx.x == 0) {
        unsigned* bar = b.bar;
        __builtin_amdgcn_s_waitcnt(0);
        unsigned nloc = b.st[0], nx = b.st[1];
        if (nloc == 0u) { xcd_barrier_complete(bar, b.x, nloc, nx); b.st[0] = nloc; b.st[1] = nx; }
        const unsigned old = xb_add(&bar[XB_XSUB(b.x)], 1u);
        const unsigned gen = old / nloc;
        if (old + 1u == (gen + 1u) * nloc) {
            __builtin_amdgcn_fence(__ATOMIC_RELEASE, "agent");
            asm volatile("s_waitcnt vmcnt(0)" ::: "memory");
            const unsigned og = xb_add(&bar[XB_TOP], 1u);
            const unsigned tg = og / nx;
            if (og + 1u == (tg + 1u) * nx) xb_add(&bar[XB_TOPGEN], 1u);
            else XB_SPIN(xb_ld(&bar[XB_TOPGEN]) == tg, bar);
            __builtin_amdgcn_fence(__ATOMIC_ACQUIRE, "agent");
            xb_add(&bar[XB_XGEN(b.x)], 1u);
            asm volatile("s_waitcnt vmcnt(0)" ::: "memory");
        } else {
            XB_SPIN(xb_ld(&bar[XB_XGEN(b.x)]) == gen, bar);
            __builtin_amdgcn_fence(__ATOMIC_ACQUIRE, "agent");
            asm volatile("s_waitcnt vmcnt(0)" ::: "memory");
        }
    }
    __syncthreads();
}

struct Frame {
    LAS unsigned char* lds;
    int tid, lane, wave, G, bx;
    const float* x; const int* pos; const float *ln_in_g, *ln_in_b, *w_in, *b_in, *sinks, *sgu_g, *sgu_b, *sgu_w, *sgu_bias, *w_out, *b_out, *ln_mix_g, *ln_mix_b, *w_gate, *w_up, *w_down, *ln_ffn_g, *ln_ffn_b;
    float* out;
    bf16 *WinT, *WoT, *WguT, *WdT, *Wsb, *XN, *Qb, *KVb, *GU, *GV, *CAT, *ACT;
    float *ST0; unsigned* ROPE; bf16 *MIX, *FFN;
};

__device__ __forceinline__ void p0_transpose_item(const float* W, int K, int N, bf16* WT, int mode, LAS float* scr, int item, int lane) {
    const int nblk = N / 32, kb = item / nblk, nb = item % nblk, k0 = 64 * kb, n0 = 32 * nb;
#pragma unroll 8
    for (int i = 0; i < 32; ++i) { const int kk = 2 * i + (lane >> 5); scr[kk * 33 + (lane & 31)] = __builtin_nontemporal_load(W + (size_t)(k0 + kk) * N + n0 + (lane & 31)); }
    LDS_WAIT(); asm volatile("" ::: "memory");
    const int c = lane & 7;
#pragma unroll
    for (int j = 0; j < 4; ++j) { const int n = (lane >> 3) + 8 * j; const LAS float* s = scr + (8 * c) * 33 + n;
        v4u o; o.x = pk2(s[0 * 33], s[1 * 33]); o.y = pk2(s[2 * 33], s[3 * 33]); o.z = pk2(s[4 * 33], s[5 * 33]); o.w = pk2(s[6 * 33], s[7 * 33]);
        const int ng = n0 + n; const int row = (mode == 0) ? ng : (((ng >> 7) << 8) + (ng & 127) + (mode == 2 ? 128 : 0));
        *(v4u*)(WT + (size_t)row * K + k0 + 8 * c) = o; }
    LDS_WAIT(); asm volatile("" ::: "memory");
}

template <int MODE, int R>
__device__ __forceinline__ void ln_rows(Frame& F, const float* src, const float* g, const float* b, bf16* ob, float* st, float* of) {
    const int gw = F.bx * NWAVES + F.wave, NGW = F.G * NWAVES;
    f32x4 gv[4], bv[4];
#pragma unroll
    for (int j = 0; j < 4; ++j) { gv[j] = *((const f32x4*)g + F.lane + 64 * j); bv[j] = *((const f32x4*)b + F.lane + 64 * j); }
    for (int m0 = gw * R; m0 < M; m0 += NGW * R) {
        f32x4 v[R][4]; float s[R], q[R];
#pragma unroll
        for (int r = 0; r < R; ++r) { const f32x4* xr = (const f32x4*)(src + (size_t)(m0 + r) * D) + F.lane;
#pragma unroll
            for (int j = 0; j < 4; ++j) v[r][j] = __builtin_nontemporal_load(xr + 64 * j); }
#pragma unroll
        for (int r = 0; r < R; ++r) { s[r] = 0.f;
#pragma unroll
            for (int j = 0; j < 4; ++j) s[r] += (v[r][j].x + v[r][j].y) + (v[r][j].z + v[r][j].w); }
#pragma unroll
        for (int r = 0; r < R; ++r) s[r] = wave_sum_u(s[r]);
#pragma unroll
        for (int r = 0; r < R; ++r) { s[r] *= (1.f / D); q[r] = 0.f;
#pragma unroll
            for (int j = 0; j < 4; ++j) { v[r][j] = v[r][j] - s[r]; q[r] += (v[r][j].x * v[r][j].x + v[r][j].y * v[r][j].y) + (v[r][j].z * v[r][j].z + v[r][j].w * v[r][j].w); } }
#pragma unroll
        for (int r = 0; r < R; ++r) q[r] = wave_sum_u(q[r]);
#pragma unroll
        for (int r = 0; r < R; ++r) {
            const float rstd = 1.f / sqrtf(q[r] * (1.f / D) + LN_EPS); const int m = m0 + r;
            if (MODE == 0) {
                v2u* o8 = (v2u*)(ob + (size_t)m * D) + F.lane;
#pragma unroll
                for (int j = 0; j < 4; ++j) { const f32x4 y = v[r][j] * rstd * gv[j] + bv[j]; v2u w; w.x = pk2(y.x, y.y); w.y = pk2(y.z, y.w); o8[64 * j] = w; }
                if (F.lane == 0) { st[2 * m] = s[r]; st[2 * m + 1] = rstd; }
            } else {
                f32x4* o = (f32x4*)(of + (size_t)m * D) + F.lane;
#pragma unroll
                for (int j = 0; j < 4; ++j) o[64 * j] = v[r][j] * rstd * gv[j] + bv[j];
            }
        }
    }
}

template <int NP, int R>
__device__ __forceinline__ void chain_rows(Frame& F, const bf16* mix, const bf16* ffn, bf16* ob, float* of) {
    const int gw = F.bx * NWAVES + F.wave, NGW = F.G * NWAVES;
    int ln = F.lane; asm volatile("" : "+v"(ln));
    for (int m0 = gw * R; m0 < M; m0 += NGW * R) {
        f32x4 v[R][4]; v2u mw[R][4], fw[R][4]; float s[R], q[R];
#pragma unroll
        for (int r = 0; r < R; ++r) { const f32x4* xr = (const f32x4*)(F.x + (size_t)(m0 + r) * D) + ln; const v2u* mr = (const v2u*)(mix + (size_t)(m0 + r) * D) + ln;
#pragma unroll
            for (int j = 0; j < 4; ++j) { v[r][j] = __builtin_nontemporal_load(xr + 64 * j); mw[r][j] = __builtin_nontemporal_load(mr + 64 * j); }
        }
#pragma unroll
        for (int pass = 0; pass < NP; ++pass) {
            if (NP == 3 && pass == 1) {
#pragma unroll
                for (int r = 0; r < R; ++r) { const v2u* fr_ = (const v2u*)(ffn + (size_t)(m0 + r) * D) + ln;
#pragma unroll
                    for (int j = 0; j < 4; ++j) fw[r][j] = __builtin_nontemporal_load(fr_ + 64 * j); } }
#pragma unroll
            for (int r = 0; r < R; ++r) { s[r] = 0.f;
#pragma unroll
                for (int j = 0; j < 4; ++j) s[r] += (v[r][j].x + v[r][j].y) + (v[r][j].z + v[r][j].w); }
#pragma unroll
            for (int r = 0; r < R; ++r) s[r] = wave_sum_u(s[r]);
#pragma unroll
            for (int r = 0; r < R; ++r) { s[r] *= (1.f / D); q[r] = 0.f;
#pragma unroll
                for (int j = 0; j < 4; ++j) { v[r][j] = v[r][j] - s[r]; q[r] += (v[r][j].x * v[r][j].x + v[r][j].y * v[r][j].y) + (v[r][j].z * v[r][j].z + v[r][j].w * v[r][j].w); } }
#pragma unroll
            for (int r = 0; r < R; ++r) q[r] = wave_sum_u(q[r]);
            float rstd[R];
#pragma unroll
            for (int r = 0; r < R; ++r) rstd[r] = 1.f / sqrtf(q[r] * (1.f / D) + LN_EPS);
            asm volatile("" ::: "memory");
            const float* gp = pass == 0 ? F.ln_in_g : (pass == 1 ? F.ln_mix_g : F.ln_ffn_g); const float* bp = pass == 0 ? F.ln_in_b : (pass == 1 ? F.ln_mix_b : F.ln_ffn_b);
#pragma unroll
            for (int j = 0; j < 4; ++j) { const f32x4 gv = *((const f32x4*)gp + ln + 64 * j), bv = *((const f32x4*)bp + ln + 64 * j);
#pragma unroll
                for (int r = 0; r < R; ++r) {
                    const f32x4 y = v[r][j] * rstd[r] * gv + bv;
                    if (pass == 0) { const f32x4 a = (f32x4){bflo(mw[r][j].x), bfhi(mw[r][j].x), bflo(mw[r][j].y), bfhi(mw[r][j].y)}; v[r][j] = y * ALPHA + a; }
                    else if (pass == 1 && NP == 2) { v2u w; w.x = pk2(y.x, y.y); w.y = pk2(y.z, y.w); *((v2u*)(ob + (size_t)(m0 + r) * D) + ln + 64 * j) = w; }
                    else if (pass == 1) { const f32x4 a = (f32x4){bflo(fw[r][j].x), bfhi(fw[r][j].x), bflo(fw[r][j].y), bfhi(fw[r][j].y)}; v[r][j] = y * ALPHA + a; }
                    else __builtin_nontemporal_store(y, (f32x4*)(of + (size_t)(m0 + r) * D) + ln + 64 * j); } }
        }
    }
}

template <int NP, int R>
__device__ __forceinline__ void cr_load(const float* x, const bf16* mix, const bf16* ffn, int m0, int ln, f32x4 (&v)[R][4], v2u (&mw)[R][4], v2u (&fw)[R][4]) {
#pragma unroll
    for (int r = 0; r < R; ++r) { const f32x4* xr = (const f32x4*)(x + (size_t)(m0 + r) * D) + ln; const v2u* mr = (const v2u*)(mix + (size_t)(m0 + r) * D) + ln;
#pragma unroll
        for (int j = 0; j < 4; ++j) { v[r][j] = __builtin_nontemporal_load(xr + 64 * j); mw[r][j] = __builtin_nontemporal_load(mr + 64 * j); }
        if (NP == 3) { const v2u* fr_ = (const v2u*)(ffn + (size_t)(m0 + r) * D) + ln;
#pragma unroll
            for (int j = 0; j < 4; ++j) fw[r][j] = __builtin_nontemporal_load(fr_ + 64 * j); } }
}
template <int NP, int R>
__device__ __forceinline__ void cr_process(const LAS float* GBL, int m0, int ln, f32x4 (&v)[R][4], v2u (&mw)[R][4], v2u (&fw)[R][4], bf16* ob, float* of) {
    float s[R], q[R], rstd[R];
#pragma unroll
    for (int pass = 0; pass < NP; ++pass) {
#pragma unroll
        for (int r = 0; r < R; ++r) { s[r] = 0.f;
#pragma unroll
            for (int j = 0; j < 4; ++j) s[r] += (v[r][j].x + v[r][j].y) + (v[r][j].z + v[r][j].w); }
#pragma unroll
        for (int r = 0; r < R; ++r) s[r] = wave_sum_u(s[r]);
#pragma unroll
        for (int r = 0; r < R; ++r) { s[r] *= (1.f / D); q[r] = 0.f;
#pragma unroll
            for (int j = 0; j < 4; ++j) { v[r][j] = v[r][j] - s[r]; q[r] += (v[r][j].x * v[r][j].x + v[r][j].y * v[r][j].y) + (v[r][j].z * v[r][j].z + v[r][j].w * v[r][j].w); } }
#pragma unroll
        for (int r = 0; r < R; ++r) q[r] = wave_sum_u(q[r]);
#pragma unroll
        for (int r = 0; r < R; ++r) rstd[r] = 1.f / sqrtf(q[r] * (1.f / D) + LN_EPS);
#pragma unroll
        for (int j = 0; j < 4; ++j) { const f32x4 gv = *(const LAS f32x4*)(GBL + (2 * pass) * 1024 + ln * 4 + 256 * j), bv = *(const LAS f32x4*)(GBL + (2 * pass + 1) * 1024 + ln * 4 + 256 * j);
#pragma unroll
            for (int r = 0; r < R; ++r) {
                const f32x4 y = v[r][j] * rstd[r] * gv + bv;
                if (pass == 0) { const f32x4 a = (f32x4){bflo(mw[r][j].x), bfhi(mw[r][j].x), bflo(mw[r][j].y), bfhi(mw[r][j].y)}; v[r][j] = y * ALPHA + a; }
                else if (pass == 1 && NP == 2) { v2u w; w.x = pk2(y.x, y.y); w.y = pk2(y.z, y.w); *((v2u*)(ob + (size_t)(m0 + r) * D) + ln + 64 * j) = w; }
                else if (pass == 1) { const f32x4 a = (f32x4){bflo(fw[r][j].x), bfhi(fw[r][j].x), bflo(fw[r][j].y), bfhi(fw[r][j].y)}; v[r][j] = y * ALPHA + a; }
                else __builtin_nontemporal_store(y, (f32x4*)(of + (size_t)(m0 + r) * D) + ln + 64 * j); } }
    }
}
template <int NP, int R>
__device__ __forceinline__ void chain_rows2(Frame& F, const bf16* mix, const bf16* ffn, bf16* ob, float* of) {
    LAS float* GBL = (LAS float*)F.lds;
    for (int i = F.tid; i < 1024; i += NWAVES * 64) { GBL[i] = F.ln_in_g[i]; GBL[1024 + i] = F.ln_in_b[i]; GBL[2048 + i] = F.ln_mix_g[i]; GBL[3072 + i] = F.ln_mix_b[i];
        if (NP == 3) { GBL[4096 + i] = F.ln_ffn_g[i]; GBL[5120 + i] = F.ln_ffn_b[i]; } }
    __syncthreads();
    int ln = F.lane; asm volatile("" : "+v"(ln));
    const int step = F.G * NWAVES * R; int m0 = (F.bx * NWAVES + F.wave) * R;
    f32x4 va[R][4], vb[R][4]; v2u ma[R][4], mb[R][4], fa[R][4], fb[R][4];
    if (m0 < M) cr_load<NP, R>(F.x, mix, ffn, m0, ln, va, ma, fa);
    while (m0 < M) {
        asm volatile("" : "+v"(ln));
        int m1 = m0 + step; if (m1 < M) cr_load<NP, R>(F.x, mix, ffn, m1, ln, vb, mb, fb);
        cr_process<NP, R>(GBL, m0, ln, va, ma, fa, ob, of);
        m0 = m1; if (m0 >= M) break;
        asm volatile("" : "+v"(ln));
        m1 = m0 + step; if (m1 < M) cr_load<NP, R>(F.x, mix, ffn, m1, ln, va, ma, fa);
        cr_process<NP, R>(GBL, m0, ln, vb, mb, fb, ob, of);
        m0 = m1;
    }
    __syncthreads();
}

constexpr int I_IN = (D / 64) * (NIN / 32), I_O = (D / 64) * (D / 32), I_G = (D / 64) * (DFF / 32), I_D = (DFF / 64) * (D / 32);
constexpr int NITEMS = I_IN + I_O + 2 * I_G + I_D;
constexpr int NWG1 = (M / 256) * (NIN / 256);
__device__ __forceinline__ void transpose_dispatch(Frame& F, int it, LAS float* scr) {
    int r = it;
    if (r < I_IN) { p0_transpose_item(F.w_in, D, NIN, F.WinT, 0, scr, r, F.lane); return; } r -= I_IN;
    if (r < I_O) { p0_transpose_item(F.w_out, D, D, F.WoT, 0, scr, r, F.lane); return; } r -= I_O;
    if (r < I_G) { p0_transpose_item(F.w_gate, D, DFF, F.WguT, 1, scr, r, F.lane); return; } r -= I_G;
    if (r < I_G) { p0_transpose_item(F.w_up, D, DFF, F.WguT, 2, scr, r, F.lane); return; } r -= I_G;
    p0_transpose_item(F.w_down, DFF, D, F.WdT, 0, scr, r, F.lane);
}
__device__ __forceinline__ void p1_tail_transposes(Frame& F) {
    const int rem = NWG1 % F.G;
    if (rem == 0 || F.bx < rem) return;
    LAS float* scr = (LAS float*)(F.lds + F.wave * 16384);
    const int tw = (F.bx - rem) * NWAVES + F.wave, NTW = (F.G - rem) * NWAVES;
    for (int it = I_IN + tw; it < NITEMS; it += NTW) transpose_dispatch(F, it, scr);
}
__device__ __forceinline__ void p0_prologue(Frame& F) {
    LAS float* scr = (LAS float*)(F.lds + F.wave * 16384);
    const int gw = F.bx * NWAVES + F.wave, NGW = F.G * NWAVES;
    const int nit0 = (NWG1 % F.G == 0) ? NITEMS : I_IN;
    for (int it = gw; it < nit0; it += NGW) transpose_dispatch(F, it, scr);
    const int gt = F.bx * (NWAVES * 64) + F.tid, NGT = F.G * NWAVES * 64;
    for (int i = gt; i < 4 * 128 * 128 / 2; i += NGT) { const int e = 2 * i, t = (e >> 7) & 127, s = e & 127; const float a = F.sgu_w[e], b = F.sgu_w[e + 1];
        ((unsigned*)F.Wsb)[i] = pk2(s <= t ? a : 0.f, (s + 1) <= t ? b : 0.f); }
    for (int i = gt; i < M * 8; i += NGT) { const int row = i >> 3, k = i & 7;
        const float invf[8] = {1.0f, 0.1939227432012558f, 0.03760603070259094f, 0.007292664609849453f, 0.0014142135623842478f, 0.00027424818836152554f, 5.3182957344688475e-05f, 1.0313385246263351e-05f};
        float fv = invf[0];
#pragma unroll
        for (int q = 1; q < 8; ++q) fv = (k == q) ? invf[q] : fv;
        const float ang = (float)F.pos[row] * fv;
        double rev = (double)ang * 0.15915494309189535; rev -= __builtin_rint(rev);
        const float fr2 = 2.0f * (float)rev;
        typedef _Float16 h16x2 __attribute__((ext_vector_type(2)));
        h16x2 cs; cs.x = (_Float16)cospif(fr2); cs.y = (_Float16)sinpif(fr2);
        F.ROPE[(size_t)row * 8 + k] = __builtin_bit_cast(unsigned, cs); }
    ln_rows<0, 8>(F, F.x, F.ln_in_g, F.ln_in_b, F.XN, F.ST0, nullptr);
}

#define MFMA16(a, b, c) __builtin_amdgcn_mfma_f32_16x16x32_bf16((a), (b), (c), 0, 0, 0)
constexpr int KS_LD = 72, VT_LD = 264;
constexpr int ATT_K_OFF = 0, ATT_V_OFF = 256 * KS_LD * 2;
__device__ __forceinline__ float h_lo(unsigned w) { return (float)__builtin_bit_cast(_Float16, (unsigned short)(w & 0xffffu)); }
__device__ __forceinline__ float h_hi(unsigned w) { return (float)__builtin_bit_cast(_Float16, (unsigned short)(w >> 16)); }
__device__ __forceinline__ v4u rope8(v4u w, v4u pw, v4u t0, v4u t1, float sg) {
    const unsigned tw[8] = {t0.x, t0.y, t0.z, t0.w, t1.x, t1.y, t1.z, t1.w};
    const unsigned ww[4] = {w.x, w.y, w.z, w.w}, pp[4] = {pw.x, pw.y, pw.z, pw.w};
    unsigned o[4];
#pragma unroll
    for (int e = 0; e < 4; ++e) {
        const float ra = bflo(ww[e]) * h_lo(tw[2 * e]) + sg * (bflo(pp[e]) * h_hi(tw[2 * e]));
        const float rb = bfhi(ww[e]) * h_lo(tw[2 * e + 1]) + sg * (bfhi(pp[e]) * h_hi(tw[2 * e + 1]));
        o[e] = pk2(ra, rb);
    }
    return (v4u){o[0], o[1], o[2], o[3]};
}
__device__ __forceinline__ void attn_unit(Frame& F, int unit) {
    const int kh = unit & 1, nb = (unit >> 1) & 31, b = unit >> 6;
    const int R0 = b * SEQ + nb * 128;
    LAS unsigned char* Ks = F.lds + ATT_K_OFF; LAS unsigned char* Vt = F.lds + ATT_V_OFF;
    const int tid = F.tid, lane = F.lane, fr = lane & 15, fq = lane >> 4;
    const int g = F.wave >> 1, qh = kh * 4 + g;
    const v4u Z4 = (v4u){0u, 0u, 0u, 0u};
    v4u qw[4], tq0[4], tq1[4]; bf16x8 q1[4];
#pragma unroll
    for (int rr = 0; rr < 4; ++rr) {
        const int r = (F.wave & 1) * 4 + rr;
        const bf16* qp = F.Qb + (size_t)(R0 + 16 * r + fr) * 512 + qh * 64 + fq * 8;
        qw[rr] = __builtin_nontemporal_load((const v4u*)(qp)); q1[rr] = __builtin_nontemporal_load((const bf16x8*)(qp + 32));
        tq0[rr] = Z4; tq1[rr] = Z4;
        if (fq < 2) { const unsigned* trow = F.ROPE + (size_t)(R0 + 16 * r + fr) * 8; tq0[rr] = *(const v4u*)trow; tq1[rr] = *(const v4u*)(trow + 4); }
    }
    v4u kw[4], kt0[4], kt1[4], vw[4];
#pragma unroll
    for (int i = 0; i < 4; ++i) {
        const int p = tid + 512 * i, key = p >> 3, ch = p & 7;
        const bool valid = (nb > 0 || key >= 128);
        kw[i] = Z4; kt0[i] = Z4; kt1[i] = Z4;
        if (valid) { kw[i] = *(const v4u*)(F.KVb + (size_t)(R0 - 128 + key) * 256 + kh * 64 + ch * 8);
            if (ch < 2) { const unsigned* trow = F.ROPE + (size_t)(R0 - 128 + key) * 8; kt0[i] = *(const v4u*)trow; kt1[i] = *(const v4u*)(trow + 4); } }
        const int keyv = p & 255, chv = p >> 8;
        vw[i] = Z4;
        if (nb > 0 || keyv >= 128) vw[i] = *(const v4u*)(F.KVb + (size_t)(R0 - 128 + keyv) * 256 + 128 + kh * 64 + chv * 8);
    }
#pragma unroll
    for (int i = 0; i < 4; ++i) {
        const int p = tid + 512 * i, key = p >> 3, ch = p & 7;
        v4u w = kw[i];
        v4u pw; pw.x = __shfl_xor(w.x, 1); pw.y = __shfl_xor(w.y, 1); pw.z = __shfl_xor(w.z, 1); pw.w = __shfl_xor(w.w, 1);
        if (ch < 2) w = rope8(w, pw, kt0[i], kt1[i], ch == 0 ? -1.f : 1.f);
        *(LAS v4u*)(Ks + (key * KS_LD + ch * 8) * 2) = w;
    }
#pragma unroll
    for (int i = 0; i < 4; ++i) {
        const int p = tid + 512 * i, key = p & 255, ch = p >> 8;
        const v4u w = vw[i];
        LAS unsigned short* vp = (LAS unsigned short*)(Vt + ((ch * 8) * VT_LD + key) * 2);
        vp[0 * VT_LD] = (unsigned short)(w.x & 0xffffu); vp[1 * VT_LD] = (unsigned short)(w.x >> 16);
        vp[2 * VT_LD] = (unsigned short)(w.y & 0xffffu); vp[3 * VT_LD] = (unsigned short)(w.y >> 16);
        vp[4 * VT_LD] = (unsigned short)(w.z & 0xffffu); vp[5 * VT_LD] = (unsigned short)(w.z >> 16);
        vp[6 * VT_LD] = (unsigned short)(w.w & 0xffffu); vp[7 * VT_LD] = (unsigned short)(w.w >> 16);
    }
    __syncthreads();
    const float sink2 = F.sinks[qh] * LOG2E;
#pragma unroll
    for (int rr = 0; rr < 4; ++rr) {
        const int r = (F.wave & 1) * 4 + rr;
        v4u qv = qw[rr];
        { v4u pw; pw.x = __shfl_xor(qv.x, 16); pw.y = __shfl_xor(qv.y, 16); pw.z = __shfl_xor(qv.z, 16); pw.w = __shfl_xor(qv.w, 16);
          if (fq < 2) qv = rope8(qv, pw, tq0[rr], tq1[rr], fq == 0 ? -1.f : 1.f); }
        const bf16x8 q0 = __builtin_bit_cast(bf16x8, qv);
        f32x4 sa[9];
#pragma unroll
        for (int t = 0; t < 9; ++t) {
            const LAS unsigned char* kp = Ks + ((16 * (r + t) + fr) * KS_LD + fq * 8) * 2;
            f32x4 a = (f32x4){0.f, 0.f, 0.f, 0.f};
            a = MFMA16(*(const LAS bf16x8*)(kp), q0, a);
            a = MFMA16(*(const LAS bf16x8*)(kp + 64), q1[rr], a);
            sa[t] = a;
        }
        float mx = sink2;
#pragma unroll
        for (int t = 0; t < 9; ++t) {
            const bool tile_ok = (nb > 0) || (r + t >= 8);
#pragma unroll
            for (int j = 0; j < 4; ++j) {
                const int diff = 16 * t + 4 * fq + j - fr;
                const bool ok = tile_ok && (diff >= 1) && (diff <= 128);
                const float s = ok ? sa[t][j] : -1e30f;
                sa[t][j] = s; mx = fmaxf(mx, s);
            }
        }
        mx = fmaxf(mx, __shfl_xor(mx, 16)); mx = fmaxf(mx, __shfl_xor(mx, 32));
        float sum = 0.f;
#pragma unroll
        for (int t = 0; t < 9; ++t)
#pragma unroll
            for (int j = 0; j < 4; ++j) { const float p = __builtin_amdgcn_exp2f(sa[t][j] - mx); sa[t][j] = p; sum += p; }
        sum += __shfl_xor(sum, 16); sum += __shfl_xor(sum, 32);
        sum += __builtin_amdgcn_exp2f(sink2 - mx);
        const float inv = 1.0f / sum;
        f32x4 oa[4];
#pragma unroll
        for (int dt = 0; dt < 4; ++dt) oa[dt] = (f32x4){0.f, 0.f, 0.f, 0.f};
#pragma unroll
        for (int kk = 0; kk < 5; ++kk) {
            const int t0 = 2 * kk, t1 = 2 * kk + 1;
            v4u pw; pw.x = pk2(sa[t0][0], sa[t0][1]); pw.y = pk2(sa[t0][2], sa[t0][3]);
            if (t1 < 9) { pw.z = pk2(sa[t1 < 9 ? t1 : 8][0], sa[t1 < 9 ? t1 : 8][1]); pw.w = pk2(sa[t1 < 9 ? t1 : 8][2], sa[t1 < 9 ? t1 : 8][3]); } else { pw.z = 0u; pw.w = 0u; }
            const bf16x8 pf = __builtin_bit_cast(bf16x8, pw);
            const int kc0 = 16 * (r + t0) + 4 * fq, kc1 = (t1 < 9) ? 16 * (r + t1) + 4 * fq : kc0;
#pragma unroll
            for (int dt = 0; dt < 4; ++dt) {
                const LAS unsigned char* vrow = Vt + ((dt * 16 + fr) * VT_LD) * 2;
                const s16x4 lo = *(const LAS s16x4*)(vrow + kc0 * 2), hi = *(const LAS s16x4*)(vrow + kc1 * 2);
                const bf16x8 vf = __builtin_shufflevector(lo, hi, 0, 1, 2, 3, 4, 5, 6, 7);
                oa[dt] = MFMA16(vf, pf, oa[dt]);
            }
        }
        bf16* op = F.CAT + (size_t)(R0 + 16 * r + fr) * 1024 + qh * 64 + 4 * fq;
#pragma unroll
        for (int dt = 0; dt < 4; ++dt) { v2u w; w.x = pk2(oa[dt][0] * inv, oa[dt][1] * inv); w.y = pk2(oa[dt][2] * inv, oa[dt][3] * inv); *(v2u*)(op + dt * 16) = w; }
    }
    __syncthreads();
}

#define LDS_BARRIER() do { asm volatile("s_waitcnt lgkmcnt(0)" ::: "memory"); __builtin_amdgcn_s_barrier(); asm volatile("" ::: "memory"); } while (0)
constexpr int SG_LD = 136;
constexpr int SG_W_OFF = 0, SG_V_OFF = 128 * SG_LD * 2;
__device__ __forceinline__ unsigned sg_off(unsigned row, unsigned ch) { return 256u * row + 16u * (ch ^ (((row & 3u) << 2) | ((row >> 2) & 3u))); }
__device__ __forceinline__ v2u tr_read_b64(unsigned addr) { v2u r; asm volatile("ds_read_b64_tr_b16 %0, %1\n\ts_waitcnt lgkmcnt(0)" : "=&v"(r) : "v"(addr) : "memory"); return r; }
__device__ __forceinline__ void sgu_unit(Frame& F, int unit) {
    const int R0 = unit * 128;
    LAS unsigned char* Wl = F.lds + SG_W_OFF; LAS unsigned char* Vv = F.lds + SG_V_OFF;
    int tid_ = F.tid; asm volatile("" : "+v"(tid_));
    const int tid = tid_, lane = tid & 63, fr = lane & 15, fq = lane >> 4, w = F.wave;
    v4u gr[16];
#pragma unroll
    for (int i = 0; i < 16; ++i) gr[i] = *(const v4u*)(F.GV + (size_t)(R0 + 16 * w + i) * 512 + lane * 8);
    const f32x4 lg0 = *(const f32x4*)(F.sgu_g + lane * 8), lg1 = *(const f32x4*)(F.sgu_g + lane * 8 + 4), lb0 = *(const f32x4*)(F.sgu_b + lane * 8), lb1 = *(const f32x4*)(F.sgu_b + lane * 8 + 4);
    v4u wr_[4]; v2u gu[2][8]; float bs[2][8];
#define SG_LOADW(h) do { _Pragma("unroll") for (int i = 0; i < 4; ++i) { const int p = tid + 512 * i; \
        wr_[i] = *(const v4u*)(F.Wsb + (size_t)(h) * 16384 + (p >> 4) * 128 + (p & 15) * 8); } } while (0)
#define GU_LOAD(h) do { _Pragma("unroll") for (int tt = 0; tt < 8; ++tt) { const int tk = 16 * tt + fr; \
        gu[(h) & 1][tt] = __builtin_nontemporal_load((const v2u*)(F.GU + (size_t)(R0 + tk) * 512 + (h) * 128 + 16 * w + 4 * fq)); bs[(h) & 1][tt] = F.sgu_bias[(h) * 128 + tk]; } } while (0)
    SG_LOADW(0);
    const float gg[8] = {lg0.x, lg0.y, lg0.z, lg0.w, lg1.x, lg1.y, lg1.z, lg1.w}, bb[8] = {lb0.x, lb0.y, lb0.z, lb0.w, lb1.x, lb1.y, lb1.z, lb1.w};
#pragma unroll
    for (int i0 = 0; i0 < 16; i0 += 4) {
        float xv[4][8], s[4], q[4];
#pragma unroll
        for (int k = 0; k < 4; ++k) { const v4u raw = gr[i0 + k];
            xv[k][0] = bflo(raw.x); xv[k][1] = bfhi(raw.x); xv[k][2] = bflo(raw.y); xv[k][3] = bfhi(raw.y); xv[k][4] = bflo(raw.z); xv[k][5] = bfhi(raw.z); xv[k][6] = bflo(raw.w); xv[k][7] = bfhi(raw.w); }
#pragma unroll
        for (int k = 0; k < 4; ++k) { s[k] = 0.f;
#pragma unroll
            for (int e = 0; e < 8; ++e) s[k] += xv[k][e]; }
#pragma unroll
        for (int k = 0; k < 4; ++k) s[k] = wave_sum_u(s[k]);
#pragma unroll
        for (int k = 0; k < 4; ++k) { s[k] *= (1.f / 512.f); q[k] = 0.f;
#pragma unroll
            for (int e = 0; e < 8; ++e) { xv[k][e] -= s[k]; q[k] += xv[k][e] * xv[k][e]; } }
#pragma unroll
        for (int k = 0; k < 4; ++k) q[k] = wave_sum_u(q[k]);
#pragma unroll
        for (int k = 0; k < 4; ++k) { const float rstd = 1.f / sqrtf(q[k] * (1.f / 512.f) + LN_EPS);
            v4u o; o.x = pk2(xv[k][0] * rstd * gg[0] + bb[0], xv[k][1] * rstd * gg[1] + bb[1]); o.y = pk2(xv[k][2] * rstd * gg[2] + bb[2], xv[k][3] * rstd * gg[3] + bb[3]);
            o.z = pk2(xv[k][4] * rstd * gg[4] + bb[4], xv[k][5] * rstd * gg[5] + bb[5]); o.w = pk2(xv[k][6] * rstd * gg[6] + bb[6], xv[k][7] * rstd * gg[7] + bb[7]);
            gr[i0 + k] = o; }
    }
    GU_LOAD(0);
    const unsigned vbase = (unsigned)(size_t)Vv;
    unsigned tra[4][2];
#pragma unroll
    for (int ks = 0; ks < 4; ++ks)
#pragma unroll
        for (int tq = 0; tq < 2; ++tq) { const unsigned q = (unsigned)(lane & 15) >> 2, p = (unsigned)lane & 3u, row = 32u * ks + 8u * (unsigned)fq + 4u * tq + q;
            tra[ks][tq] = vbase + sg_off(row, 2u * (unsigned)w + (p >> 1)) + 8u * (p & 1u); }
#pragma unroll
    for (int h = 0; h < 4; ++h) {
#pragma unroll
        for (int i = 0; i < 4; ++i) { const int p = tid + 512 * i, t = p >> 4, ch = p & 15;
            *(LAS v4u*)(Wl + (t * SG_LD + ch * 8) * 2) = wr_[i]; }
        if (fq == h) {
#pragma unroll
            for (int i = 0; i < 16; ++i) *(LAS v4u*)(Vv + sg_off((unsigned)(16 * w + i), (unsigned)fr)) = gr[i];
        }
        LDS_BARRIER();
        if (h < 3) { SG_LOADW(h + 1); GU_LOAD(h + 1); }
        const int c4 = h * 128 + 16 * w + 4 * fq;
        f32x4 acc[8];
#pragma unroll
        for (int tt = 0; tt < 8; ++tt) acc[tt] = (f32x4){0.f, 0.f, 0.f, 0.f};
#pragma unroll
        for (int ks = 0; ks < 4; ++ks) {
            const v2u a0 = tr_read_b64(tra[ks][0]), a1 = tr_read_b64(tra[ks][1]);
            const v4u aw = (v4u){a0.x, a0.y, a1.x, a1.y};
            const bf16x8 af = __builtin_bit_cast(bf16x8, aw);
#pragma unroll
            for (int tt = 0; tt < 8; ++tt) if (tt >= 2 * ks) {
                const bf16x8 bfr = *(const LAS bf16x8*)(Wl + ((16 * tt + fr) * SG_LD + ks * 32 + fq * 8) * 2);
                acc[tt] = MFMA16(af, bfr, acc[tt]);
            }
        }
#pragma unroll
        for (int tt = 0; tt < 8; ++tt) { const int tk = 16 * tt + fr; const v2u gw2 = gu[h & 1][tt]; const float bsv = bs[h & 1][tt];
            v2u o; o.x = pk2(bflo(gw2.x) * (acc[tt][0] + bsv), bfhi(gw2.x) * (acc[tt][1] + bsv)); o.y = pk2(bflo(gw2.y) * (acc[tt][2] + bsv), bfhi(gw2.y) * (acc[tt][3] + bsv));
            *(v2u*)(F.CAT + (size_t)(R0 + tk) * 1024 + 512 + c4) = o; }
        LDS_BARRIER();
    }
#undef SG_LOADW
#undef GU_LOAD
}

struct Args { const void* in[20]; float* out; unsigned char* ws; };
__global__ void __launch_bounds__(NWAVES * 64, 2) hybrid_fwd(Args args) {
    extern __shared__ __attribute__((aligned(16))) unsigned char lds[];
    cg::grid_group grid = cg::this_grid();
    Frame F;
    F.lds = (LAS unsigned char*)lds;
    F.tid = threadIdx.x; F.lane = F.tid & 63; F.wave = __builtin_amdgcn_readfirstlane(F.tid >> 6);
    F.G = gridDim.x; F.bx = blockIdx.x;
    unsigned char* ws = args.ws;
    F.x = (const float*)args.in[0]; F.pos = (const int*)args.in[1]; F.ln_in_g = (const float*)args.in[2]; F.ln_in_b = (const float*)args.in[3];
    F.w_in = (const float*)args.in[4]; F.b_in = (const float*)args.in[5]; F.sinks = (const float*)args.in[6]; F.sgu_g = (const float*)args.in[7]; F.sgu_b = (const float*)args.in[8];
    F.sgu_w = (const float*)args.in[9]; F.sgu_bias = (const float*)args.in[10]; F.w_out = (const float*)args.in[11]; F.b_out = (const float*)args.in[12];
    F.ln_mix_g = (const float*)args.in[13]; F.ln_mix_b = (const float*)args.in[14]; F.w_gate = (const float*)args.in[15]; F.w_up = (const float*)args.in[16]; F.w_down = (const float*)args.in[17];
    F.ln_ffn_g = (const float*)args.in[18]; F.ln_ffn_b = (const float*)args.in[19]; F.out = args.out;
    F.WinT = (bf16*)(ws + WS_WIN); F.WoT = (bf16*)(ws + WS_WO); F.WguT = (bf16*)(ws + WS_WGU); F.WdT = (bf16*)(ws + WS_WD); F.Wsb = (bf16*)(ws + WS_WS);
    F.ST0 = (float*)(ws + WS_ST0); F.ROPE = (unsigned*)(ws + WS_ROPE); F.MIX = (bf16*)(ws + WS_MIX); F.FFN = (bf16*)(ws + WS_FFN);
    F.XN = (bf16*)(ws + WS_XN); F.Qb = (bf16*)(ws + WS_Q); F.KVb = (bf16*)(ws + WS_KV); F.GU = (bf16*)(ws + WS_GU); F.GV = (bf16*)(ws + WS_GV);
    F.CAT = (bf16*)(ws + WS_CAT); F.ACT = (bf16*)(ws + WS_ACT);

    volatile LAS unsigned* bst = (volatile LAS unsigned*)(F.lds + LDS_BYTES - 64);
    if (F.tid < 16) bst[F.tid] = 0u;
    unsigned* barw = (unsigned*)(ws + WS_BAR);
    __syncthreads();
    XcdBarrier bar = xcd_barrier_post(barw, bst);
    if (args.ws == nullptr) grid.sync();
    p0_prologue(F);
#define GRID_BAR() xcd_barrier(bar)
    GRID_BAR();
    { pg8::Gemm g{F.XN, F.WinT, M, NIN, D}; pg8::StaticOrder S; S.init(M, NIN, F.G, F.bx);
      pg8::EpiIn E{F.Qb, F.KVb, F.GU, F.GV, F.b_in, QSCALE};
      pg8::gemm_phase<pg8::EpiIn, pg8::StaticOrder, true, true>(F.lds, g, S, E); }
    p1_tail_transposes(F);
    GRID_BAR();
    for (int u = F.bx; u < BATCH * 32; u += F.G) sgu_unit(F, u);
    for (int u = F.bx; u < BATCH * 32 * 2; u += F.G) attn_unit(F, u);
    GRID_BAR();
    { pg8::Gemm g{F.CAT, F.WoT, M, D, D}; pg8::StaticOrder S; S.init(M, D, F.G, F.bx);
      pg8::EpiPlainBf16 E{F.MIX, D, F.b_out};
      pg8::gemm_phase<pg8::EpiPlainBf16, pg8::StaticOrder, false, true>(F.lds, g, S, E); }
    GRID_BAR();
    chain_rows2<2, 2>(F, F.MIX, nullptr, F.XN, nullptr);
    GRID_BAR();
    { pg8::Gemm g{F.XN, F.WguT, M, NGU, D}; pg8::StaticOrder S; S.init(M, NGU, F.G, F.bx);
      pg8::EpiSwiglu E{F.ACT, DFF};
      pg8::gemm_phase<pg8::EpiSwiglu, pg8::StaticOrder, false, true>(F.lds, g, S, E); }
    GRID_BAR();
    { pg8::Gemm g{F.ACT, F.WdT, M, D, DFF}; pg8::StaticOrder S; S.init(M, D, F.G, F.bx);
      pg8::EpiPlainBf16 E{F.FFN, D, nullptr};
      pg8::gemm_phase<pg8::EpiPlainBf16, pg8::StaticOrder, false, true>(F.lds, g, S, E); }
    GRID_BAR();
    chain_rows2<3, 2>(F, F.MIX, F.FFN, nullptr, F.out);
}

extern "C" void kernel_launch(void* const* d_in, const int* in_sizes, int n_in, void* d_out, int out_size, void* d_ws, size_t ws_size, hipStream_t stream) {
    static int grid = 0;
    if (grid == 0) {
        if (n_in != 20 || in_sizes[0] != M * D || out_size != M * D || ws_size < WS_END) { fprintf(stderr, "kernel_launch: unexpected shapes (n_in %d, in0 %d, out %d, ws %zu)\n", n_in, n_in > 0 ? in_sizes[0] : -1, out_size, ws_size); grid = -1; return; }
        int dev = 0, cus = 0, per_cu = 0;
        (void)hipGetDevice(&dev); (void)hipDeviceGetAttribute(&cus, hipDeviceAttributeMultiprocessorCount, dev);
        if (hipFuncSetAttribute((const void*)hybrid_fwd, hipFuncAttributeMaxDynamicSharedMemorySize, LDS_BYTES) != hipSuccess) { fprintf(stderr, "kernel_launch: hipFuncSetAttribute failed\n"); grid = -1; return; }
        if (hipOccupancyMaxActiveBlocksPerMultiprocessor(&per_cu, (const void*)hybrid_fwd, NWAVES * 64, LDS_BYTES) != hipSuccess || per_cu < 1) { fprintf(stderr, "kernel_launch: occupancy query says %d\n", per_cu); per_cu = 1; }
        (void)hipGetLastError();
        grid = cus * per_cu;
    }
    if (grid < 0) return;
    Args a{};
    for (int i = 0; i < 20; ++i) a.in[i] = d_in[i];
    a.out = (float*)d_out; a.ws = (unsigned char*)d_ws;
    if (hipMemsetAsync((char*)d_ws + WS_BAR, 0, 16384, stream) != hipSuccess) { fprintf(stderr, "kernel_launch: memset failed\n"); return; }
    void* kargs[] = {&a};
    const hipError_t e = hipLaunchCooperativeKernel((const void*)hybrid_fwd, dim3(grid), dim3(NWAVES * 64), kargs, LDS_BYTES, stream);
    if (e != hipSuccess) fprintf(stderr, "kernel_launch: cooperative launch failed: %s (grid %d)\n", hipGetErrorString(e), grid);
}
```
